# Optimizing an MI355X kernel written in HIP

```python
import math
import jax, jax.numpy as jnp
from jax import lax
import numpy as np

D_MODEL = 1024
BATCH = 8
SEQ = 4096
DEPTH = 2
DEC_BATCH = 32
DEC_SEQ = 8
PAST_LEN = 16384
PAGE_SIZE = 128

N_A_LAYERS = DEPTH // 2
N_B_LAYERS = DEPTH - N_A_LAYERS
MLSTM_HEADS = 4
MLSTM_INNER = 2 * D_MODEL
MLSTM_HEAD_DIM = MLSTM_INNER // MLSTM_HEADS
MLSTM_CHUNK = 64
GROUPS = ((128, 1), (512, 4), (2048, 16))
N_GROUPS = len(GROUPS)
GROUP_HEADS = 8
ATTN_HEAD_DIM = 64
N_Q_HEADS = N_GROUPS * GROUP_HEADS
ATTN_OUT = GROUP_HEADS * ATTN_HEAD_DIM
ATTN_BLOCK = 128
N_BUCKETS = 32
MAX_DISTANCE = 2048
EPS = 1e-6

kernel_name = 'yoco_mlstm_dilated_swa_step'


def _rmsnorm(x, g):
    xf = x.astype(jnp.float32)
    y = xf * lax.rsqrt(jnp.mean(xf * xf, axis=-1, keepdims=True) + EPS)
    return (y * g.astype(jnp.float32)).astype(x.dtype)


def _t5_bucket(dist):
    exact = N_BUCKETS // 2
    d = jnp.maximum(dist, 1).astype(jnp.float32)
    large = exact + (jnp.log(d / exact) / math.log(MAX_DISTANCE / exact) * (N_BUCKETS - exact)).astype(jnp.int32)
    return jnp.where(dist < exact, dist, jnp.minimum(large, N_BUCKETS - 1))


def _mlstm_scan(q, k, v, ig, lf, C0, n0, m0):
    B, T, H, Dh = q.shape
    L = min(MLSTM_CHUNK, T)
    pad = (-T) % L
    if pad:
        q = jnp.pad(q, ((0, 0), (0, pad), (0, 0), (0, 0)))
        k = jnp.pad(k, ((0, 0), (0, pad), (0, 0), (0, 0)))
        v = jnp.pad(v, ((0, 0), (0, pad), (0, 0), (0, 0)))
        ig = jnp.pad(ig, ((0, 0), (0, pad), (0, 0)), constant_values=-jnp.inf)
        lf = jnp.pad(lf, ((0, 0), (0, pad), (0, 0)))
    nc = (T + pad) // L

    def chunks(a):
        a = a.reshape((B, nc, L) + a.shape[2:])
        return jnp.moveaxis(a, (1, 2), (0, 3))

    causal = jnp.tril(jnp.ones((L, L), dtype=bool))

    def step(carry, xs):
        C, n, m = carry
        qc, kc, vc, igc, lfc = xs
        b = jnp.cumsum(lfc, axis=-1)
        log_inter = b + m[..., None]
        log_d = jnp.where(causal, b[..., :, None] - b[..., None, :] + igc[..., None, :], -jnp.inf)
        m_t = jnp.maximum(log_inter, jnp.max(log_d, axis=-1))
        dmat = jnp.exp(log_d - m_t[..., None])
        inter = jnp.exp(log_inter - m_t)
        s = jnp.einsum('bhtd,bhsd->bhts', qc, kc) * dmat
        num = jnp.einsum('bhts,bhse->bhte', s, vc) + inter[..., None] * jnp.einsum('bhtd,bhde->bhte', qc, C)
        den = jnp.sum(s, axis=-1) + inter * jnp.einsum('bhtd,bhd->bht', qc, n)
        h = num / jnp.maximum(jnp.abs(den), jnp.exp(-m_t))[..., None]
        m_new = m_t[..., -1]
        w_in = jnp.exp(b[..., -1:] - b + igc - m_new[..., None])
        decay = jnp.exp(b[..., -1] + m - m_new)
        C_new = decay[..., None, None] * C + jnp.einsum('bhsd,bhse->bhde', kc * w_in[..., None], vc)
        n_new = decay[..., None] * n + jnp.einsum('bhsd,bhs->bhd', kc, w_in)
        return (C_new, n_new, m_new), h

    (C, n, m), hs = lax.scan(step, (C0, n0, m0), (chunks(q), chunks(k), chunks(v), chunks(ig), chunks(lf)))
    hs = jnp.moveaxis(hs, (0, 3), (1, 2)).reshape(B, nc * L, H, Dh)[:, :T]
    return hs, (C, n, m)


def _mlstm_layer(x, C0, n0, m0, norm_g, w_in, b_gates, h_gain, w_out):
    f32 = jnp.float32
    B, T, _ = x.shape
    H, Dh, DI = MLSTM_HEADS, MLSTM_HEAD_DIM, MLSTM_INNER
    p = _rmsnorm(x, norm_g) @ w_in
    q, k, v, o, z = (p[..., i * DI:(i + 1) * DI] for i in range(5))
    gates = p[..., 5 * DI:].astype(f32) + b_gates.astype(f32)
    ig = gates[..., :H]
    lf = jax.nn.log_sigmoid(gates[..., H:])
    heads = lambda a: a.astype(f32).reshape(B, T, H, Dh)
    h, (C, n, m) = _mlstm_scan(heads(q), heads(k) * (Dh ** -0.5), heads(v), ig, lf,
                               C0.astype(f32), n0.astype(f32), m0.astype(f32))
    h = h * lax.rsqrt(jnp.mean(h * h, axis=-1, keepdims=True) + EPS)
    h = h.reshape(B, T, DI) * h_gain.astype(f32)
    y = (h * jax.nn.sigmoid(o.astype(f32)) * jax.nn.silu(z.astype(f32))).astype(x.dtype) @ w_out
    return x + y, C, n, m


def _shared_kv(x, norm_g, w_kv, k_gain):
    B, T, _ = x.shape
    p = _rmsnorm(x, norm_g) @ w_kv
    k = _rmsnorm(p[..., :N_Q_HEADS * ATTN_HEAD_DIM].reshape(B, T, N_Q_HEADS, ATTN_HEAD_DIM), k_gain)
    v = p[..., N_Q_HEADS * ATTN_HEAD_DIM:].reshape(B, T, N_Q_HEADS, ATTN_HEAD_DIM)
    return k, v


def _b_query(x, norm_g, w_in, q_gain):
    B, T, _ = x.shape
    p = _rmsnorm(x, norm_g) @ w_in
    q = _rmsnorm(p[..., :N_Q_HEADS * ATTN_HEAD_DIM].reshape(B, T, N_Q_HEADS, ATTN_HEAD_DIM), q_gain)
    z = p[..., N_Q_HEADS * ATTN_HEAD_DIM:]
    return q, z


def _group_prompt(q, k, v, bias_tab, win, dil):
    B, T, GH, HD = q.shape
    J = win // dil
    span = dil * ATTN_BLOCK
    Tp = -(-T // span) * span
    pad = Tp - T
    S = Tp // dil
    nb = S // ATTN_BLOCK
    padt = lambda a: jnp.pad(a, ((0, 0), (0, pad), (0, 0), (0, 0)))

    def blocks(a):
        a = a.reshape(B, S, dil, GH, HD).transpose(0, 2, 1, 3, 4)
        return a.reshape(B * dil, nb, ATTN_BLOCK, GH, HD)

    def with_prev(a):
        prev = jnp.concatenate([jnp.zeros_like(a[:, :1]), a[:, :-1]], axis=1)
        return jnp.concatenate([prev, a], axis=2)

    qb = blocks(padt(q))
    kc = with_prev(blocks(padt(k)))
    vc = with_prev(blocks(padt(v)))
    qi = jnp.arange(ATTN_BLOCK)[:, None]
    kj = jnp.arange(2 * ATTN_BLOCK)[None, :]
    rel = qi + ATTN_BLOCK - kj
    band = (rel >= 0) & (rel <= J)
    valid = band[None] & ((jnp.arange(nb) > 0)[:, None, None] | (kj >= ATTN_BLOCK)[None])
    bias = bias_tab.astype(jnp.float32)[_t5_bucket(jnp.clip(rel, 0, J) * dil)]
    s = jnp.einsum('bnqhd,bnkhd->bnhqk', qb, kc).astype(jnp.float32) * (HD ** -0.5)
    s = s + jnp.moveaxis(bias, -1, 0)[None, None]
    s = jnp.where(valid[None, :, None], s, -jnp.inf)
    lse = jax.nn.logsumexp(s, axis=-1)
    p = jnp.exp(s - lse[..., None])
    o = jnp.einsum('bnhqk,bnkhd->bnqhd', p.astype(vc.dtype), vc)
    o = o.reshape(B, dil, S, GH, HD).transpose(0, 2, 1, 3, 4).reshape(B, Tp, GH, HD)[:, :T]
    lse = jnp.moveaxis(lse, 2, 3).reshape(B, dil, S, GH).transpose(0, 2, 1, 3).reshape(B, Tp, GH)[:, :T]
    return o, lse


def _group_sample(q, k_new, v_new, buf, bias_tab, win, dil):
    B, S, GH, HD = q.shape
    L = buf.shape[1]
    J = win // dil
    k_all = jnp.concatenate([buf[:, :, 0].astype(k_new.dtype), k_new], axis=1)
    v_all = jnp.concatenate([buf[:, :, 1].astype(v_new.dtype), v_new], axis=1)
    j = jnp.arange(J + 1)
    idx = L + jnp.arange(S)[:, None] - dil * j[None, :]
    valid = idx >= 0
    idx = jnp.maximum(idx, 0)
    kg = k_all[:, idx]
    vg = v_all[:, idx]
    bias = bias_tab.astype(jnp.float32)[_t5_bucket(dil * j)]
    s = jnp.einsum('bshd,bsjhd->bshj', q, kg).astype(jnp.float32) * (HD ** -0.5) + bias.T[None, None]
    s = jnp.where(valid[None, :, None, :], s, -jnp.inf)
    lse = jax.nn.logsumexp(s, axis=-1)
    p = jnp.exp(s - lse[..., None])
    o = jnp.einsum('bshj,bsjhd->bshd', p.astype(vg.dtype), vg)
    return o, lse


def _merge(x, outs, lses, z, w_out):
    B, T, _ = x.shape
    w = jax.nn.softmax(jnp.stack(lses, axis=0), axis=0)
    o = jnp.sum(w[..., None] * jnp.stack(outs, axis=0).astype(jnp.float32), axis=0)
    y = (o.reshape(B, T, ATTN_OUT) * jax.nn.silu(z.astype(jnp.float32))).astype(x.dtype) @ w_out
    return x + y


def _dilated_layer_prompt(x, k, v, norm_g, w_in, q_gain, rel_bias, w_out):
    q, z = _b_query(x, norm_g, w_in, q_gain)
    outs, lses = [], []
    for g, (win, dil) in enumerate(GROUPS):
        sl = slice(g * GROUP_HEADS, (g + 1) * GROUP_HEADS)
        o, lse = _group_prompt(q[:, :, sl], k[:, :, sl], v[:, :, sl], rel_bias[:, sl], win, dil)
        outs.append(o)
        lses.append(lse)
    return _merge(x, outs, lses, z, w_out)


def _dilated_layer_sample(x, k, v, bufs, norm_g, w_in, q_gain, rel_bias, w_out):
    q, z = _b_query(x, norm_g, w_in, q_gain)
    outs, lses = [], []
    for g, (win, dil) in enumerate(GROUPS):
        sl = slice(g * GROUP_HEADS, (g + 1) * GROUP_HEADS)
        o, lse = _group_sample(q[:, :, sl], k[:, :, sl], v[:, :, sl], bufs[g], rel_bias[:, sl], win, dil)
        outs.append(o)
        lses.append(lse)
    return _merge(x, outs, lses, z, w_out)


def _window_rows(k, v, g):
    win = GROUPS[g][0]
    sl = slice(g * GROUP_HEADS, (g + 1) * GROUP_HEADS)
    rows = min(win, k.shape[1])
    return jnp.stack([k[:, -rows:, sl], v[:, -rows:, sl]], axis=2)


def _new_rows(k, v, g):
    sl = slice(g * GROUP_HEADS, (g + 1) * GROUP_HEADS)
    return jnp.stack([k[:, :, sl], v[:, :, sl]], axis=2)


def setup_inputs(seed: int = 0) -> dict:
    key = jax.random.key(seed)
    ks = jax.random.split(key, 24)
    f32 = jnp.float32
    nrm = lambda kk, shape, scale=1.0: scale * jax.random.normal(kk, shape, f32)
    H, Dh, DI = MLSTM_HEADS, MLSTM_HEAD_DIM, MLSTM_INNER
    QW = N_Q_HEADS * ATTN_HEAD_DIM
    wl = [min(w, PAST_LEN) for w, _ in GROUPS]
    b_gates = jnp.concatenate([nrm(ks[11], (N_A_LAYERS, H), 0.1),
                               jnp.linspace(3.0, 6.0, H)[None, :] + nrm(ks[12], (N_A_LAYERS, H), 0.1)], axis=-1)
    return {
        'x_prompt': nrm(ks[0], (BATCH, SEQ, D_MODEL)),
        'x_sample': nrm(ks[1], (DEC_BATCH, DEC_SEQ, D_MODEL)),
        'state_mlstm_C': nrm(ks[2], (N_A_LAYERS, DEC_BATCH, H, Dh, Dh), Dh ** -0.5),
        'state_mlstm_n': nrm(ks[3], (N_A_LAYERS, DEC_BATCH, H, Dh), Dh ** -0.5),
        'state_mlstm_m': nrm(ks[4], (N_A_LAYERS, DEC_BATCH, H)),
        'cache_kv_w128': nrm(ks[5], (DEC_BATCH, wl[0], 2, GROUP_HEADS, ATTN_HEAD_DIM)),
        'cache_kv_w512': nrm(ks[6], (DEC_BATCH, wl[1], 2, GROUP_HEADS, ATTN_HEAD_DIM)),
        'cache_kv_w2048': nrm(ks[7], (DEC_BATCH, wl[2], 2, GROUP_HEADS, ATTN_HEAD_DIM)),
        'norm_a': 1.0 + nrm(ks[8], (N_A_LAYERS, D_MODEL), 0.02),
        'w_in_a': nrm(ks[9], (N_A_LAYERS, D_MODEL, 5 * DI + 2 * H), D_MODEL ** -0.5),
        'b_gates_a': b_gates,
        'hnorm_a': 1.0 + nrm(ks[10], (N_A_LAYERS, DI), 0.02),
        'w_out_a': nrm(ks[13], (N_A_LAYERS, DI, D_MODEL), DI ** -0.5),
        'norm_kv': 1.0 + nrm(ks[14], (D_MODEL,), 0.02),
        'w_kv': nrm(ks[15], (D_MODEL, 2 * QW), D_MODEL ** -0.5),
        'k_norm': 1.0 + nrm(ks[16], (ATTN_HEAD_DIM,), 0.02),
        'norm_b': 1.0 + nrm(ks[17], (N_B_LAYERS, D_MODEL), 0.02),
        'w_in_b': nrm(ks[18], (N_B_LAYERS, D_MODEL, QW + ATTN_OUT), D_MODEL ** -0.5),
        'q_norm': 1.0 + nrm(ks[19], (N_B_LAYERS, ATTN_HEAD_DIM), 0.02),
        'rel_bias': nrm(ks[20], (N_BUCKETS, N_Q_HEADS), 0.5),
        'w_out_b': nrm(ks[21], (N_B_LAYERS, ATTN_OUT, D_MODEL), ATTN_OUT ** -0.5),
    }


def reference(x_prompt, x_sample, state_mlstm_C, state_mlstm_n, state_mlstm_m,
              cache_kv_w128, cache_kv_w512, cache_kv_w2048,
              norm_a, w_in_a, b_gates_a, hnorm_a, w_out_a,
              norm_kv, w_kv, k_norm,
              norm_b, w_in_b, q_norm, rel_bias, w_out_b):
    f32 = jnp.float32
    bufs = (cache_kv_w128, cache_kv_w512, cache_kv_w2048)
    n_p = x_prompt.shape[0]
    xp, xs = x_prompt, x_sample
    Cp, Np, Mp, Cs, Ns, Ms = [], [], [], [], [], []
    kp = vp = ks = vs = None
    for layer in range(DEPTH):
        if layer < N_A_LAYERS:
            a = (norm_a[layer], w_in_a[layer], b_gates_a[layer], hnorm_a[layer], w_out_a[layer])
            zero_C = jnp.zeros((n_p, MLSTM_HEADS, MLSTM_HEAD_DIM, MLSTM_HEAD_DIM), f32)
            zero_n = jnp.zeros((n_p, MLSTM_HEADS, MLSTM_HEAD_DIM), f32)
            zero_m = jnp.zeros((n_p, MLSTM_HEADS), f32)
            xp, c, n, m = _mlstm_layer(xp, zero_C, zero_n, zero_m, *a)
            Cp.append(c)
            Np.append(n)
            Mp.append(m)
            xs, c, n, m = _mlstm_layer(xs, state_mlstm_C[layer], state_mlstm_n[layer], state_mlstm_m[layer], *a)
            Cs.append(c)
            Ns.append(n)
            Ms.append(m)
            if layer == N_A_LAYERS - 1:
                kp, vp = _shared_kv(xp, norm_kv, w_kv, k_norm)
                ks, vs = _shared_kv(xs, norm_kv, w_kv, k_norm)
        else:
            i = layer - N_A_LAYERS
            b = (norm_b[i], w_in_b[i], q_norm[i], rel_bias, w_out_b[i])
            xp = _dilated_layer_prompt(xp, kp, vp, *b)
            xs = _dilated_layer_sample(xs, ks, vs, bufs, *b)
    kv128_p, kv512_p, kv2048_p = [_window_rows(kp, vp, g) for g in range(N_GROUPS)]
    kv128_s, kv512_s, kv2048_s = [_new_rows(ks, vs, g) for g in range(N_GROUPS)]
    return (xp, xs, jnp.stack(Cp), jnp.stack(Np), jnp.stack(Mp), jnp.stack(Cs), jnp.stack(Ns), jnp.stack(Ms),
            kv128_p, kv512_p, kv2048_p, kv128_s, kv512_s, kv2048_s)
```

```cpp
#include <hip/hip_runtime.h>
#include <hip/hip_cooperative_groups.h>
#include <cstdio>
#include <cstdint>
namespace cg = cooperative_groups;

#define GAS __attribute__((address_space(1)))
#define LAS __attribute__((address_space(3)))
#define DI __device__ __forceinline__
typedef unsigned short bf16;
typedef short bf16x8 __attribute__((ext_vector_type(8)));
typedef short s16x4 __attribute__((ext_vector_type(4)));
typedef float f32x4 __attribute__((ext_vector_type(4)));
typedef float f32x2 __attribute__((ext_vector_type(2)));
typedef float f32x16 __attribute__((ext_vector_type(16)));
typedef unsigned v4u __attribute__((ext_vector_type(4)));
typedef unsigned v2u __attribute__((ext_vector_type(2)));
#define LDS_WAIT() asm volatile("s_waitcnt lgkmcnt(0)" ::: "memory")
#define VM_WAIT() asm volatile("s_waitcnt vmcnt(0)" ::: "memory")
#define MFMA32(a, b, c) __builtin_amdgcn_mfma_f32_32x32x16_bf16((a), (b), (c), 0, 0, 0)
#define MFMA16(a, b, c) __builtin_amdgcn_mfma_f32_16x16x32_bf16((a), (b), (c), 0, 0, 0)

typedef __bf16 bf16x2_t __attribute__((ext_vector_type(2)));
DI unsigned pk2(float lo, float hi) { return __builtin_bit_cast(unsigned, __builtin_convertvector((f32x2){lo, hi}, bf16x2_t)); }
DI unsigned f2bf(float f) { return pk2(f, 0.f) & 0xffffu; }
DI float bf_lo(unsigned u) { return __builtin_bit_cast(float, u << 16); }
DI float bf_hi(unsigned u) { return __builtin_bit_cast(float, u & 0xffff0000u); }
DI float xsum16(float s) { float a = s, b = s; asm("s_nop 1\n\tv_permlane16_swap_b32 %0, %1" : "+v"(a), "+v"(b)); return a + b; }
DI float xsum32(float s) { float a = s, b = s; asm("s_nop 1\n\tv_permlane32_swap_b32 %0, %1" : "+v"(a), "+v"(b)); return a + b; }
DI float xmax16(float s) { float a = s, b = s; asm("s_nop 1\n\tv_permlane16_swap_b32 %0, %1" : "+v"(a), "+v"(b)); return fmaxf(a, b); }
DI float xmax32(float s) { float a = s, b = s; asm("s_nop 1\n\tv_permlane32_swap_b32 %0, %1" : "+v"(a), "+v"(b)); return fmaxf(a, b); }
DI float wave_sum(float v) {
#pragma unroll
    for (int o = 1; o < 16; o <<= 1) v += __shfl_xor(v, o);
    return xsum32(xsum16(v));
}
DI int lane_id() { int l; asm volatile("v_mbcnt_lo_u32_b32 %0, -1, 0\n\tv_mbcnt_hi_u32_b32 %0, -1, %0" : "=v"(l)); return l; }
DI float fsigmoid(float x) { return __builtin_amdgcn_rcpf(1.0f + __builtin_amdgcn_exp2f(-1.4426950408889634f * x)); }
DI float fgate(float o, float z) { return z * __builtin_amdgcn_rcpf((1.0f + __builtin_amdgcn_exp2f(-1.4426950408889634f * o)) * (1.0f + __builtin_amdgcn_exp2f(-1.4426950408889634f * z))); }

constexpr int D = 1024, BATCH = 8, SEQ = 4096, DECB = 32, DECS = 8;
constexpr int TP = BATCH * SEQ, TS = DECB * DECS, M = TP + TS;
constexpr int NH = 4, DI_ = 2048, DH = 512;
constexpr int NP1 = 5 * DI_;
constexpr int WIN_LD = NP1 + 2 * NH;
constexpr int QW = 1536, N2 = 2 * QW + QW + 512;
constexpr int HD = 64, GH = 8, NQH = 24, AOUT = 512;
constexpr float EPS = 1e-6f;

constexpr size_t O_Y = 0;
constexpr size_t O_CP = (size_t)M * D;
constexpr size_t O_NP = O_CP + (size_t)BATCH * NH * DH * DH;
constexpr size_t O_MP = O_NP + (size_t)BATCH * NH * DH;
constexpr size_t O_CS = O_MP + BATCH * NH;
constexpr size_t O_NS = O_CS + (size_t)DECB * NH * DH * DH;
constexpr size_t O_MS = O_NS + (size_t)DECB * NH * DH;
constexpr size_t O_KV128P = O_MS + DECB * NH;
constexpr size_t O_KV512P = O_KV128P + (size_t)BATCH * 128 * 1024;
constexpr size_t O_KV2048P = O_KV512P + (size_t)BATCH * 512 * 1024;
constexpr size_t O_KV128S = O_KV2048P + (size_t)BATCH * 2048 * 1024;
constexpr size_t O_KV512S = O_KV128S + (size_t)TS * 1024;
constexpr size_t O_KV2048S = O_KV512S + (size_t)TS * 1024;
constexpr size_t O_END = O_KV2048S + (size_t)TS * 1024;

constexpr size_t MiB = 1u << 20;
constexpr size_t WS_CTL = 0;
constexpr size_t WS_WA = 1 * MiB;
constexpr size_t WS_WOA = 21 * MiB;
constexpr size_t WS_W2 = 25 * MiB;
constexpr size_t WS_WOB = 35 * MiB;
constexpr size_t WS_XN = 36 * MiB;
constexpr size_t WS_GATES = 101 * MiB;
constexpr size_t WS_RNORM = 103 * MiB;
constexpr size_t WS_HSS = 966 * MiB;
constexpr size_t WS_SS1 = 124 * MiB;
constexpr size_t WS_A3 = 127 * MiB;
constexpr size_t WS_P1 = 256 * MiB;
constexpr size_t WS_KVQZ = 256 * MiB;
constexpr size_t WS_OG = 579 * MiB;
constexpr size_t WS_LSE = 676 * MiB;
constexpr size_t WS_A5 = 680 * MiB;
constexpr size_t WS_SCALG = 901 * MiB;
constexpr size_t WS_NEED = 984 * MiB;

constexpr size_t P1_V = (size_t)TP * 4096, P1_PART = (size_t)TP * 2048, P1_S = P1_V + 3 * P1_PART;
constexpr int LDS_BYTES = 163840;
constexpr int NTHR = 512;

struct Params { const float* in[21]; float* out; unsigned char* ws; };


typedef GAS unsigned gu32;
#define XB_TMO      128
#define XB_XCNT(j)  (256  + 64 * (j))
#define XB_XSUB(j)  (1280 + 64 * (j))
#define XB_XGEN(j)  (2304 + 64 * (j))
#define XB_TOP      3328
#define XB_TOPGEN   3392
#define XCD_BAR_WORDS 3456
#define XB_SPIN_CAP (1u << 18)

__device__ __forceinline__ unsigned xb_ld(unsigned* p)              { return __hip_atomic_load(p, __ATOMIC_RELAXED, __HIP_MEMORY_SCOPE_AGENT); }
__device__ __forceinline__ unsigned xb_add(unsigned* p, unsigned v) { return __hip_atomic_fetch_add(p, v, __ATOMIC_RELAXED, __HIP_MEMORY_SCOPE_AGENT); }
__device__ __forceinline__ unsigned xb_xcc_id() { return (unsigned)__builtin_amdgcn_s_getreg((3 << 11) | 20) & 0xFu; }
#define XB_SPIN(cond, bar) do { unsigned _sp = 0; while (cond) { __builtin_amdgcn_s_sleep(1); \
    if ((++_sp & 255u) == 0u) { if (xb_ld(&(bar)[XB_TMO])) break; if (_sp > XB_SPIN_CAP) { atomicAdd(&(bar)[XB_TMO], 1u); break; } } } } while (0)

struct XcdBarrier {
    unsigned* bar; unsigned x;
    volatile LAS unsigned* st;
};

__device__ __forceinline__ XcdBarrier xcd_barrier_post(unsigned* bar, volatile LAS unsigned* st) {
    XcdBarrier b; b.bar = bar; b.x = xb_xcc_id(); b.st = st;
    if (threadIdx.x == 0) (void)xb_add(&bar[XB_XCNT(b.x)], 1u);
    return b;
}
__device__ __forceinline__ void xcd_barrier_complete(unsigned* bar, unsigned x, unsigned& nloc, unsigned& nx) {
    const unsigned G = gridDim.x * gridDim.y * gridDim.z;
    unsigned sum, cnt, mine, sp = 0u;
    for (;;) {
        sum = 0u; cnt = 0u; mine = 0u;
#pragma unroll
        for (unsigned j = 0; j < 16; ++j) { const unsigned c = xb_ld(&bar[XB_XCNT(j)]); sum += c; cnt += (c > 0u) ? 1u : 0u; mine = (j == x) ? c : mine; }
        if (sum == G) break;
        __builtin_amdgcn_s_sleep(1);
        if ((++sp & 255u) == 0u) { if (xb_ld(&bar[XB_TMO])) break; if (sp > XB_SPIN_CAP) { atomicAdd(&bar[XB_TMO], 1u); break; } }
    }
    nloc = mine > 0u ? mine : 1u; nx = cnt > 0u ? cnt : 1u;
}

__device__ __forceinline__ void xcd_barrier(const XcdBarrier& b) {
    asm volatile("s_waitcnt vmcnt(0)" ::: "memory");
    __syncthreads();
    if (threadIdx.x == 0) {
        unsigned* bar = b.bar;
        __builtin_amdgcn_s_waitcnt(0);
        unsigned nloc = b.st[0], nx = b.st[1];
        if (nloc == 0u) { xcd_barrier_complete(bar, b.x, nloc, nx); b.st[0] = nloc; b.st[1] = nx; }
        const unsigned old = xb_add(&bar[XB_XSUB(b.x)], 1u);
        const unsigned gen = old / nloc;
        if (old + 1u == (gen + 1u) * nloc) {
            __builtin_amdgcn_fence(__ATOMIC_RELEASE, "agent");
            asm volatile("s_waitcnt vmcnt(0)" ::: "memory");
            const unsigned og = xb_add(&bar[XB_TOP], 1u);
            const unsigned tg = og / nx;
            if (og + 1u == (tg + 1u) * nx) xb_add(&bar[XB_TOPGEN], 1u);
            else XB_SPIN(xb_ld(&bar[XB_TOPGEN]) == tg, bar);
            __builtin_amdgcn_fence(__ATOMIC_ACQUIRE, "agent");
            xb_add(&bar[XB_XGEN(b.x)], 1u);
            asm volatile("s_waitcnt vmcnt(0)" ::: "memory");
        } else {
            XB_SPIN(xb_ld(&bar[XB_XGEN(b.x)]) == gen, bar);
            __builtin_amdgcn_fence(__ATOMIC_ACQUIRE, "agent");
            asm volatile("s_waitcnt vmcnt(0)" ::: "memory");
        }
    }
    __syncthreads();
}

namespace pg8 {
constexpr int BM = 256, BK = 64, HALF = 128, HTB = HALF * BK * 2, STAGE_BYTES = 8 * HTB, NXCD = 8, WGM = 8;
constexpr int XTAB = STAGE_BYTES;
__host__ __device__ __forceinline__ int lds_byte(int r, int c) { const int st = (r >> 4) * 2 + (c >> 5), rr = r & 15, cc = c & 31, ob = rr * 64 + cc * 2; return st * 1024 + (ob ^ (((ob >> 9) & 1) << 5)); }
__host__ __device__ __forceinline__ void stage_rc(int b, int& R, int& C) { const int st = b / 1024, sb = b % 1024, swz = sb ^ (((sb >> 9) & 1) << 5); R = (st >> 1) * 16 + swz / 64; C = (st & 1) * 32 + (swz % 64) / 2; }
__host__ __device__ __forceinline__ int perm32(int rho) { const int n = rho >> 4, i = rho & 15; return 8 * (i >> 2) + 4 * n + (i & 3); }

struct Unit { int pm, pn; };
struct Gemm { const bf16* A; const bf16* Bt; int M, N, K; };
struct StaticOrder {
    int nM, nN, nwg, G, c;
    __device__ void init(int M_, int N_, int G_, int c_) { nM = M_ / BM; nN = N_ / BM; nwg = nM * nN; G = G_; c = c_; }
    __device__ bool next(int i, Unit& u) const {
        const long L = (long)i * G + c; if (L >= nwg) return false;
        int wgid = (int)L; { const int q = nwg / NXCD, r = nwg % NXCD, xcd = wgid % NXCD, off = wgid / NXCD; wgid = (xcd < r ? xcd * (q + 1) : r * (q + 1) + (xcd - r) * q) + off; }
        const int nig = WGM * nN, gid = wgid / nig, fm = gid * WGM, gsz = (nM - fm) < WGM ? (nM - fm) : WGM;
        u.pm = fm + ((wgid % nig) % gsz); u.pn = (wgid % nig) / gsz; return true;
    }
};
DI unsigned cvt_pk_bf16(float lo, float hi) { return pk2(lo, hi); }

template <class Epi, bool ALIGN_EPI, bool SP2>
DI void gemm_phase(LAS unsigned char* lds, const Gemm g, const StaticOrder& S, const Epi& E, int wv) {
    int tid_ = (wv << 6) | lane_id(); asm volatile("" : "+v"(tid_)); const int tid = tid_, wid = __builtin_amdgcn_readfirstlane(tid >> 6), lane = tid & 63, wr = wid >> 2, wc = wid & 3, fr = lane & 15, fq = lane >> 4;
    const int K = g.K, nt = K / BK;
    unsigned voffA[2], voffB[2];
#pragma unroll
    for (int i = 0; i < 2; ++i) { int R, C; stage_rc(tid * 16 + i * 8192, R, C); const int Rb = Epi::PERM ? ((R & ~31) + perm32(R & 31)) : R;
        voffA[i] = (unsigned)(R * K + C) * 2u; voffB[i] = (unsigned)(Rb * K + C) * 2u; }
    const size_t kstep = (size_t)(BK * 2);
    const size_t hstep = (size_t)HALF * K * 2;
    const size_t tstep = 2 * hstep;
    const unsigned ldsw = (unsigned)wid * 1024u;
    const int aoff = lds_byte(wr * 64 + fr, fq * 8), boff = lds_byte(wc * 32 + fr, fq * 8);
#define PG8_SA(b, h) (((b) * 2 + (h)) * HTB)
#define PG8_SB(b, h) ((4 + (b) * 2 + (h)) * HTB)
#define PG8_STAGE(bufoff, gbase, voff) do { _Pragma("unroll") for (int _i = 0; _i < 2; ++_i) \
        __builtin_amdgcn_global_load_lds((const unsigned*)((const char*)(gbase) + (voff)[_i]), (LAS unsigned*)(lds + (bufoff) + ldsw + _i * 8192), 16, 0, 0); } while (0)
#define PG8_LDA(dst, b, h) do { _Pragma("unroll") for (int m = 0; m < 4; ++m) _Pragma("unroll") for (int k = 0; k < 2; ++k) dst[m][k] = *(const LAS bf16x8*)(lds + PG8_SA(b, h) + aoff + m * 2048 + k * 1024); } while (0)
#define PG8_LDB(dst, b, h) do { _Pragma("unroll") for (int n = 0; n < 2; ++n) _Pragma("unroll") for (int k = 0; k < 2; ++k) dst[n][k] = *(const LAS bf16x8*)(lds + PG8_SB(b, h) + boff + n * 2048 + k * 1024); } while (0)
#define PG8_MMA(ai, bj, At, Bt) do { __builtin_amdgcn_s_setprio(1); _Pragma("unroll") for (int m = 0; m < 4; ++m) _Pragma("unroll") for (int n = 0; n < 2; ++n) _Pragma("unroll") for (int k = 0; k < 2; ++k) \
        acc[ai][bj][m][n] = __builtin_amdgcn_mfma_f32_16x16x32_bf16(Bt[n][k], At[m][k], acc[ai][bj][m][n], 0, 0, 0); __builtin_amdgcn_s_setprio(0); } while (0)
#define PG8_WAIT_V(n) asm volatile("s_waitcnt vmcnt(" #n ")" ::: "memory")
#define PG8_WAIT_L(n) asm volatile("s_waitcnt lgkmcnt(" #n ")" ::: "memory")
#define PG8_BAR __builtin_amdgcn_s_barrier()
#define PG8_SCHED __builtin_amdgcn_sched_barrier(0)
    Unit cur, nxt; int ui = 0;
    if (!S.next(0, cur)) return;
    f32x4 acc[2][2][4][2];
#pragma unroll
    for (int a = 0; a < 2; ++a)
#pragma unroll
        for (int b = 0; b < 2; ++b)
#pragma unroll
            for (int m = 0; m < 4; ++m)
#pragma unroll
                for (int n = 0; n < 2; ++n) acc[a][b][m][n] = (f32x4){0.f, 0.f, 0.f, 0.f};
    bf16x8 At[4][2], B0[2][2], B1[2][2];
    const char* cA = (const char*)g.A + (size_t)cur.pm * tstep; const char* cB = (const char*)g.Bt + (size_t)cur.pn * tstep;
    if constexpr (Epi::HAS_PREP) E.prep(cur, 0, lds, tid);
    if constexpr (SP2) {
        PG8_STAGE(PG8_SB(0, 0), cB, voffB); PG8_STAGE(PG8_SB(0, 1), cB + hstep, voffB); PG8_STAGE(PG8_SA(0, 0), cA, voffA); PG8_STAGE(PG8_SA(0, 1), cA + hstep, voffA);
        if (wr == 1) PG8_BAR;
        PG8_WAIT_V(2); PG8_BAR;
        PG8_STAGE(PG8_SB(1, 0), cB + kstep, voffB); PG8_STAGE(PG8_SA(1, 0), cA + kstep, voffA); PG8_STAGE(PG8_SB(1, 1), cB + hstep + kstep, voffB);
        PG8_WAIT_V(6); PG8_BAR;
    } else {
        PG8_STAGE(PG8_SB(0, 0), cB, voffB); PG8_STAGE(PG8_SA(0, 0), cA, voffA); PG8_STAGE(PG8_SB(0, 1), cB + hstep, voffB); PG8_STAGE(PG8_SA(0, 1), cA + hstep, voffA);
        if (wr == 1) PG8_BAR;
        PG8_WAIT_V(4); PG8_BAR;
        PG8_STAGE(PG8_SB(1, 0), cB + kstep, voffB); PG8_STAGE(PG8_SA(1, 0), cA + kstep, voffA); PG8_STAGE(PG8_SB(1, 1), cB + hstep + kstep, voffB);
        PG8_WAIT_V(6); PG8_BAR;
    }
    for (;;) {
        const bool has_next = S.next(ui + 1, nxt);
        const char* nA = has_next ? (const char*)g.A + (size_t)nxt.pm * tstep : cA; const char* nB = has_next ? (const char*)g.Bt + (size_t)nxt.pn * tstep : cB;
        for (int t = 0; t < nt; t += 2) {
            const bool last = (t == nt - 2);
            const char* a1 = cA + (size_t)(t + 1) * kstep;
            const char* a2 = last ? nA : cA + (size_t)(t + 2) * kstep; const char* b2 = last ? nB : cB + (size_t)(t + 2) * kstep;
            const char* a3 = a2 + kstep; const char* b3 = b2 + kstep;
            if constexpr (Epi::HAS_PREP) { if (last && has_next) E.prep(nxt, ui + 1, lds, tid); }
            if constexpr (SP2) {
            PG8_LDB(B0, 0, 0); PG8_LDB(B1, 0, 1); PG8_SCHED; PG8_LDA(At, 0, 0); PG8_STAGE(PG8_SA(1, 1), a1 + hstep, voffA);
            PG8_WAIT_V(8); PG8_WAIT_L(0); PG8_BAR; PG8_MMA(0, 0, At, B0); PG8_MMA(0, 1, At, B1); PG8_BAR; PG8_SCHED;
            PG8_LDA(At, 0, 1); PG8_STAGE(PG8_SB(0, 0), b2, voffB); PG8_STAGE(PG8_SB(0, 1), b2 + hstep, voffB); PG8_STAGE(PG8_SA(0, 0), a2, voffA);
            PG8_WAIT_V(8); PG8_WAIT_L(0); PG8_BAR; PG8_MMA(1, 0, At, B0); PG8_MMA(1, 1, At, B1); PG8_BAR; PG8_SCHED;
            PG8_LDB(B0, 1, 0); PG8_LDB(B1, 1, 1); PG8_SCHED; PG8_LDA(At, 1, 0); PG8_STAGE(PG8_SA(0, 1), a2 + hstep, voffA);
            PG8_WAIT_V(8); PG8_WAIT_L(0); PG8_BAR; PG8_MMA(0, 0, At, B0); PG8_MMA(0, 1, At, B1); PG8_BAR; PG8_SCHED;
            PG8_LDA(At, 1, 1); PG8_STAGE(PG8_SB(1, 0), b3, voffB); PG8_STAGE(PG8_SB(1, 1), b3 + hstep, voffB); PG8_STAGE(PG8_SA(1, 0), a3, voffA);
            PG8_WAIT_V(8); PG8_WAIT_L(0); PG8_BAR; PG8_MMA(1, 0, At, B0); PG8_MMA(1, 1, At, B1); PG8_BAR; PG8_SCHED;
            } else {
            PG8_LDB(B0, 0, 0); PG8_SCHED; PG8_LDA(At, 0, 0); PG8_STAGE(PG8_SA(1, 1), a1 + hstep, voffA);
            PG8_WAIT_L(8); PG8_BAR; PG8_WAIT_L(0); PG8_MMA(0, 0, At, B0); PG8_BAR; PG8_SCHED;
            PG8_LDB(B1, 0, 1); PG8_STAGE(PG8_SB(0, 0), b2, voffB);
            PG8_BAR; PG8_WAIT_L(0); PG8_MMA(0, 1, At, B1); PG8_BAR;
            PG8_LDA(At, 0, 1); PG8_STAGE(PG8_SA(0, 0), a2, voffA);
            PG8_BAR; PG8_WAIT_L(0); PG8_MMA(1, 0, At, B0); PG8_BAR; PG8_SCHED;
            PG8_STAGE(PG8_SB(0, 1), b2 + hstep, voffB);
            PG8_WAIT_V(6); PG8_BAR; PG8_MMA(1, 1, At, B1); PG8_BAR;
            PG8_LDB(B0, 1, 0); PG8_SCHED; PG8_LDA(At, 1, 0); PG8_STAGE(PG8_SA(0, 1), a2 + hstep, voffA);
            PG8_WAIT_L(8); PG8_BAR; PG8_WAIT_L(0); PG8_MMA(0, 0, At, B0); PG8_BAR; PG8_SCHED;
            PG8_LDB(B1, 1, 1); PG8_STAGE(PG8_SB(1, 0), b3, voffB);
            PG8_BAR; PG8_WAIT_L(0); PG8_MMA(0, 1, At, B1); PG8_BAR;
            PG8_LDA(At, 1, 1); PG8_STAGE(PG8_SA(1, 0), a3, voffA);
            PG8_BAR; PG8_WAIT_L(0); PG8_MMA(1, 0, At, B0); PG8_BAR; PG8_SCHED;
            PG8_STAGE(PG8_SB(1, 1), b3 + hstep, voffB);
            PG8_WAIT_V(6); PG8_BAR; PG8_MMA(1, 1, At, B1); PG8_BAR;
            }
            if constexpr (Epi::RESCALE) { if ((((t + 2) & 7) == 0) && !last) E.rescale(acc, ((t + 2) >> 3) - 1, ui, lds, wr, fr); }
        }
        if constexpr (ALIGN_EPI) { if (wr == 0) PG8_BAR; }
        E(acc, cur, ui, lds, wr, wc, fr, fq);
        if (!has_next) break;
#pragma unroll
        for (int a = 0; a < 2; ++a)
#pragma unroll
            for (int b = 0; b < 2; ++b)
#pragma unroll
                for (int m = 0; m < 4; ++m)
#pragma unroll
                    for (int n = 0; n < 2; ++n) acc[a][b][m][n] = (f32x4){0.f, 0.f, 0.f, 0.f};
        cur = nxt; cA = nA; cB = nB; ++ui;
        if constexpr (ALIGN_EPI) { if (wr == 1) PG8_BAR; }
    }
    PG8_WAIT_V(0);
    if constexpr (!ALIGN_EPI) { if (wr == 0) PG8_BAR; }
    PG8_BAR;
#undef PG8_SA
#undef PG8_SB
#undef PG8_STAGE
#undef PG8_LDA
#undef PG8_LDB
#undef PG8_MMA
#undef PG8_WAIT_V
#undef PG8_WAIT_L
#undef PG8_BAR
#undef PG8_SCHED
}


constexpr int XSCR = XTAB + 8192;
DI void wave_xpose(LAS unsigned char* scr, int fr, int c0, int c1, v4u p0, v4u p1, int lane, v4u& o0, v4u& o1) {
    *(LAS v4u*)(scr + fr * 128 + ((c0 ^ (fr & 7)) << 4)) = p0;
    *(LAS v4u*)(scr + fr * 128 + ((c1 ^ (fr & 7)) << 4)) = p1;
    asm volatile("s_waitcnt lgkmcnt(0)" ::: "memory");
    const int r = lane >> 3, c = lane & 7;
    o0 = *(const LAS v4u*)(scr + r * 128 + ((c ^ (r & 7)) << 4));
    o1 = *(const LAS v4u*)(scr + (r + 8) * 128 + ((c ^ (r & 7)) << 4));
    asm volatile("s_waitcnt lgkmcnt(0)" ::: "memory");
}
struct EpiP1 {
    static constexpr bool PERM = true, HAS_PREP = false, RESCALE = false;
    bf16* O; int ldc;
    DI void prep(const Unit&, int, LAS unsigned char*, int) const {}
    DI void rescale(f32x4 (&)[2][2][4][2], int, int, LAS unsigned char*, int, int) const {}
    DI void operator()(const f32x4 (&acc)[2][2][4][2], const Unit& u, int, LAS unsigned char* lds, int wr, int wc, int fr, int fq) const {
        const int lane = fr + 16 * fq, wid = wr * 4 + wc;
        LAS unsigned char* scr = lds + XSCR + wid * 2048;
        const int rr = lane >> 3, cc = lane & 7;
        const int col = u.pn * BM + 64 * wc + 8 * cc;
        const int part = col >> 11, hh = (col >> 9) & 3, d = col & 511;
#pragma unroll
        for (int ai = 0; ai < 2; ++ai)
#pragma unroll
            for (int m = 0; m < 4; ++m) { const f32x4 a0 = acc[ai][0][m][0], a1 = acc[ai][0][m][1], b0 = acc[ai][1][m][0], b1 = acc[ai][1][m][1];
                v4u p0, p1; p0.x = cvt_pk_bf16(a0[0], a0[1]); p0.y = cvt_pk_bf16(a0[2], a0[3]); p0.z = cvt_pk_bf16(a1[0], a1[1]); p0.w = cvt_pk_bf16(a1[2], a1[3]);
                p1.x = cvt_pk_bf16(b0[0], b0[1]); p1.y = cvt_pk_bf16(b0[2], b0[3]); p1.z = cvt_pk_bf16(b1[0], b1[1]); p1.w = cvt_pk_bf16(b1[2], b1[3]);
                v4u o[2]; wave_xpose(scr, fr, fq, 4 + fq, p0, p1, lane, o[0], o[1]);
#pragma unroll
                for (int h = 0; h < 2; ++h) { const int row = u.pm * BM + ai * HALF + wr * 64 + m * 16 + rr + 8 * h; size_t off;
                    if (row >= TP) off = P1_S + (size_t)(row - TP) * NP1 + col;
                    else { const int b = row >> 12, c = (row >> 6) & 63, t = row & 63;
                        if (part < 2) off = ((((size_t)(4 * c + (d >> 7)) * 32 + (b * 4 + hh)) * 2) + part) * 8192 + t * 128 + (d & 127);
                        else off = P1_V + (size_t)(part - 2) * P1_PART + (((size_t)c * 32 + (b * 4 + hh)) * 8 + (d >> 6)) * 4096 + t * 64 + (d & 63); }
                    *(v4u*)(O + off) = o[h]; } }
    }
};

struct EpiG3 {
    static constexpr bool PERM = false, HAS_PREP = true, RESCALE = true;
    const float* hss;
    const bf16* xn; const float* rnorm;
    float* out;
    bf16* xb;
    float* ss1;
    DI void prep(const Unit& u, int ui, LAS unsigned char* lds, int tid) const {
        LAS float* T = (LAS float*)(lds + XTAB + (ui & 1) * 4096);
        if (tid < 256) {
            const float* p = hss + (size_t)(u.pm * BM + tid) * 32; float f[4];
#pragma unroll
            for (int h = 0; h < 4; ++h) { float s = 0.f;
#pragma unroll
                for (int j = 0; j < 2; ++j) { const f32x4 v = *(const f32x4*)(p + h * 8 + j * 4); s += (v[0] + v[1]) + (v[2] + v[3]); }
                f[h] = __builtin_amdgcn_rsqf(s * (1.0f / 512.0f) + EPS); }
            *(LAS f32x4*)(T + tid * 4) = (f32x4){f[0] / f[1], f[1] / f[2], f[2] / f[3], f[3]};
        }
        asm volatile("s_waitcnt vmcnt(0) lgkmcnt(0)" ::: "memory"); __builtin_amdgcn_s_barrier(); asm volatile("" ::: "memory");
    }
    DI void rescale(f32x4 (&acc)[2][2][4][2], int seg, int ui, LAS unsigned char* lds, int wr, int fr) const {
        const LAS float* T = (const LAS float*)(lds + XTAB + (ui & 1) * 4096);
#pragma unroll
        for (int ai = 0; ai < 2; ++ai)
#pragma unroll
            for (int m = 0; m < 4; ++m) { const float r = T[(ai * HALF + wr * 64 + m * 16 + fr) * 4 + seg];
#pragma unroll
                for (int bj = 0; bj < 2; ++bj)
#pragma unroll
                    for (int n = 0; n < 2; ++n) acc[ai][bj][m][n] = acc[ai][bj][m][n] * r; }
    }
    DI void operator()(const f32x4 (&acc)[2][2][4][2], const Unit& u, int ui, LAS unsigned char* lds, int wr, int wc, int fr, int fq) const {
        const LAS float* T = (const LAS float*)(lds + XTAB + (ui & 1) * 4096);
        const int lane = fr + 16 * fq, wid = wr * 4 + wc;
        LAS unsigned char* scr = lds + XSCR + wid * 2048;
        const int rr = lane >> 3, cc = lane & 7;
        v2u xv[2][2][2]; float rn[2][2];
        auto xoff = [&](int ai, int m, int bj, int h) -> size_t { return (size_t)(u.pm * BM + ai * HALF + wr * 64 + m * 16 + rr + 8 * h) * D + u.pn * BM + bj * HALF + wc * 32 + 4 * cc; };
#pragma unroll
        for (int h = 0; h < 2; ++h) { rn[0][h] = rnorm[u.pm * BM + wr * 64 + rr + 8 * h];
#pragma unroll
            for (int bj = 0; bj < 2; ++bj) xv[0][bj][h] = *(const v2u*)(xn + xoff(0, 0, bj, h)); }
#pragma unroll
        for (int gi = 0; gi < 8; ++gi) { const int ai = gi >> 2, m = gi & 3;
            if (gi < 7) {
#pragma unroll
                for (int h = 0; h < 2; ++h) { rn[(gi + 1) & 1][h] = rnorm[u.pm * BM + ((gi + 1) >> 2) * HALF + wr * 64 + ((gi + 1) & 3) * 16 + rr + 8 * h];
#pragma unroll
                    for (int bj = 0; bj < 2; ++bj) xv[(gi + 1) & 1][bj][h] = *(const v2u*)(xn + xoff((gi + 1) >> 2, (gi + 1) & 3, bj, h)); } }
            const float r = T[(ai * HALF + wr * 64 + m * 16 + fr) * 4 + 3];
            float ssq[2] = {0.f, 0.f};
#pragma unroll
            for (int bj = 0; bj < 2; ++bj) { v4u o0, o1;
                wave_xpose(scr, fr, fq, 4 + fq, __builtin_bit_cast(v4u, acc[ai][bj][m][0] * r), __builtin_bit_cast(v4u, acc[ai][bj][m][1] * r), lane, o0, o1);
#pragma unroll
                for (int h = 0; h < 2; ++h) { const int row = u.pm * BM + ai * HALF + wr * 64 + m * 16 + rr + 8 * h; const int c = u.pn * BM + bj * HALF + wc * 32 + 4 * cc;
                    const v2u xq = xv[gi & 1][bj][h]; const float rnh = rn[gi & 1][h];
                    const f32x4 o = (f32x4){bf_lo(xq.x), bf_hi(xq.x), bf_lo(xq.y), bf_hi(xq.y)} * rnh + __builtin_bit_cast(f32x4, h ? o1 : o0);
                    ssq[h] += (o[0] * o[0] + o[1] * o[1]) + (o[2] * o[2] + o[3] * o[3]);
                    v2u w; w.x = cvt_pk_bf16(o[0], o[1]); w.y = cvt_pk_bf16(o[2], o[3]); *(v2u*)(xb + (size_t)row * D + c) = w; } }
#pragma unroll
            for (int h = 0; h < 2; ++h) { float s = ssq[h]; s += __shfl_xor(s, 1); s += __shfl_xor(s, 2); s += __shfl_xor(s, 4);
                if (cc == 0) ss1[(size_t)(u.pm * BM + ai * HALF + wr * 64 + m * 16 + rr + 8 * h) * 16 + u.pn * 4 + wc] = s; }
        }
    }
};

struct EpiG4 {
    static constexpr bool PERM = true, HAS_PREP = true, RESCALE = false;
    const float* ss1;
    const float* kgain; const float* qgain;
    bf16* O;
    float* out;
    DI void prep(const Unit& u, int ui, LAS unsigned char* lds, int tid) const {
        LAS float* T = (LAS float*)(lds + XTAB + (ui & 1) * 4096);
        if (tid < 256) { const float* p = ss1 + (size_t)(u.pm * BM + tid) * 16; float s = 0.f;
#pragma unroll
            for (int j = 0; j < 4; ++j) { const f32x4 v = *(const f32x4*)(p + j * 4); s += (v[0] + v[1]) + (v[2] + v[3]); }
            T[tid] = __builtin_amdgcn_rsqf(s * (1.0f / 1024.0f) + EPS); }
        asm volatile("s_waitcnt vmcnt(0) lgkmcnt(0)" ::: "memory"); __builtin_amdgcn_s_barrier(); asm volatile("" ::: "memory");
    }
    DI void rescale(f32x4 (&)[2][2][4][2], int, int, LAS unsigned char*, int, int) const {}
    DI void operator()(const f32x4 (&acc)[2][2][4][2], const Unit& u, int ui, LAS unsigned char* lds, int wr, int wc, int fr, int fq) const {
        const LAS float* T = (const LAS float*)(lds + XTAB + (ui & 1) * 4096);
        const int pn = u.pn; const int kind = pn < 6 ? 0 : (pn < 12 ? 1 : (pn < 18 ? 2 : 3));
        const bool normed = (kind == 0 || kind == 2);
        const float* gp = (kind == 0) ? kgain : qgain;
        f32x4 gv[2][2];
#pragma unroll
        for (int bj = 0; bj < 2; ++bj)
#pragma unroll
            for (int n = 0; n < 2; ++n) gv[bj][n] = normed ? *(const f32x4*)(gp + 32 * bj + 8 * fq + 4 * n) : (f32x4){1.f, 1.f, 1.f, 1.f};
        const int lcol = pn * BM + 64 * wc + 8 * fq;
        const int head = (kind < 2) ? ((pn - 6 * kind) * 4 + wc) : 0;
        const int grp = head >> 3, hs = head & 7;
        const int wrows = grp == 0 ? 128 : (grp == 1 ? 512 : 2048);
        const size_t obase_p = grp == 0 ? O_KV128P : (grp == 1 ? O_KV512P : O_KV2048P);
        const size_t obase_s = grp == 0 ? O_KV128S : (grp == 1 ? O_KV512S : O_KV2048S);
#pragma unroll
        for (int ai = 0; ai < 2; ++ai)
#pragma unroll
            for (int m = 0; m < 4; ++m) { const int rl = ai * HALF + wr * 64 + m * 16 + fr; const int row = u.pm * BM + rl; const float rs = T[rl];
                f32x4 x[2][2]; float ssq = 0.f;
#pragma unroll
                for (int bj = 0; bj < 2; ++bj)
#pragma unroll
                    for (int n = 0; n < 2; ++n) { x[bj][n] = acc[ai][bj][m][n] * rs; ssq += (x[bj][n][0] * x[bj][n][0] + x[bj][n][1] * x[bj][n][1]) + (x[bj][n][2] * x[bj][n][2] + x[bj][n][3] * x[bj][n][3]); }
                if (normed) { ssq = xsum32(xsum16(ssq)); const float hr = __builtin_amdgcn_rsqf(ssq * (1.0f / 64.0f) + EPS);
#pragma unroll
                    for (int bj = 0; bj < 2; ++bj)
#pragma unroll
                        for (int n = 0; n < 2; ++n) x[bj][n] = x[bj][n] * hr * gv[bj][n]; }
                bf16* rowp = O + (size_t)row * N2 + lcol;
#pragma unroll
                for (int bj = 0; bj < 2; ++bj) { v4u w; w.x = cvt_pk_bf16(x[bj][0][0], x[bj][0][1]); w.y = cvt_pk_bf16(x[bj][0][2], x[bj][0][3]); w.z = cvt_pk_bf16(x[bj][1][0], x[bj][1][1]); w.w = cvt_pk_bf16(x[bj][1][2], x[bj][1][3]);
                    *(v4u*)(rowp + 32 * bj) = w; }
                if (kind < 2) {
                    float* dst = nullptr;
                    if (row >= TP) dst = out + obase_s + (size_t)(row - TP) * 1024 + kind * 512 + hs * 64;
                    else { const int b = row >> 12, t = row & 4095; if (t >= SEQ - wrows) dst = out + obase_p + ((size_t)b * wrows + (t - (SEQ - wrows))) * 1024 + kind * 512 + hs * 64; }
                    if (dst) {
#pragma unroll
                        for (int bj = 0; bj < 2; ++bj)
#pragma unroll
                            for (int n = 0; n < 2; ++n) *(f32x4*)(dst + 32 * bj + 8 * fq + 4 * n) = x[bj][n]; }
                }
                asm volatile("" ::: "memory"); }
    }
};

struct EpiG5 {
    static constexpr bool PERM = false, HAS_PREP = false, RESCALE = false;
    float* out; const bf16* xb;
    DI void prep(const Unit&, int, LAS unsigned char*, int) const {}
    DI void rescale(f32x4 (&)[2][2][4][2], int, int, LAS unsigned char*, int, int) const {}
    DI void operator()(const f32x4 (&acc)[2][2][4][2], const Unit& u, int, LAS unsigned char* lds, int wr, int wc, int fr, int fq) const {
        const int lane = fr + 16 * fq, wid = wr * 4 + wc;
        LAS unsigned char* scr = lds + XSCR + wid * 2048;
        const int rr = lane >> 3, cc = lane & 7;
        v2u xv[2][2][2];
        auto xoff = [&](int ai, int m, int bj, int h) -> size_t { return (size_t)(u.pm * BM + ai * HALF + wr * 64 + m * 16 + rr + 8 * h) * D + u.pn * BM + bj * HALF + wc * 32 + 4 * cc; };
#pragma unroll
        for (int bj = 0; bj < 2; ++bj)
#pragma unroll
            for (int h = 0; h < 2; ++h) xv[0][bj][h] = *(const v2u*)(xb + xoff(0, 0, bj, h));
#pragma unroll
        for (int gi = 0; gi < 8; ++gi) { const int ai = gi >> 2, m = gi & 3;
            if (gi < 7) {
#pragma unroll
                for (int bj = 0; bj < 2; ++bj)
#pragma unroll
                    for (int h = 0; h < 2; ++h) xv[(gi + 1) & 1][bj][h] = *(const v2u*)(xb + xoff((gi + 1) >> 2, (gi + 1) & 3, bj, h)); }
#pragma unroll
            for (int bj = 0; bj < 2; ++bj) { v4u o0, o1;
                wave_xpose(scr, fr, fq, 4 + fq, __builtin_bit_cast(v4u, acc[ai][bj][m][0]), __builtin_bit_cast(v4u, acc[ai][bj][m][1]), lane, o0, o1);
#pragma unroll
                for (int h = 0; h < 2; ++h) { const v2u xq = xv[gi & 1][bj][h]; const f32x4 x1 = (f32x4){bf_lo(xq.x), bf_hi(xq.x), bf_lo(xq.y), bf_hi(xq.y)};
                    *(f32x4*)(out + xoff(ai, m, bj, h)) = x1 + __builtin_bit_cast(f32x4, h ? o1 : o0); } }
        }
    }
};
}

DI void p0_tr_item(const float* W, int ldw, int ncol0, int K, const float* gain, float cscale, bf16* WT, int drow0, LAS float* scr, int kb, int lane) {
    const int k0 = 64 * kb;
    f32x4 wv_[8];
#pragma unroll
    for (int i = 0; i < 8; ++i) wv_[i] = *(const f32x4*)(W + (size_t)(k0 + 8 * i + (lane >> 3)) * ldw + ncol0 + 4 * (lane & 7));
#pragma unroll
    for (int i = 0; i < 8; ++i) { const int kk = 8 * i + (lane >> 3); const float gsc = (gain ? gain[k0 + kk] : 1.0f) * cscale; LAS float* d = scr + kk * 33 + 4 * (lane & 7);
        d[0] = wv_[i][0] * gsc; d[1] = wv_[i][1] * gsc; d[2] = wv_[i][2] * gsc; d[3] = wv_[i][3] * gsc; }
    LDS_WAIT(); asm volatile("" ::: "memory");
    const int c = lane & 7;
#pragma unroll
    for (int j = 0; j < 4; ++j) { const int n = (lane >> 3) + 8 * j; const LAS float* s = scr + (8 * c) * 33 + n;
        v4u o; o.x = pk2(s[0 * 33], s[1 * 33]); o.y = pk2(s[2 * 33], s[3 * 33]); o.z = pk2(s[4 * 33], s[5 * 33]); o.w = pk2(s[6 * 33], s[7 * 33]);
        *(v4u*)(WT + (size_t)(drow0 + n) * K + k0 + 8 * c) = o; }
    LDS_WAIT(); asm volatile("" ::: "memory");
}

DI void p0_phase(const Params& P, LAS unsigned char* lds, int vcu, int G, int wv) {
    int tid_ = (wv << 6) | lane_id(); asm volatile("" : "+v"(tid_)); const int tid = tid_, lane = tid & 63, wave = __builtin_amdgcn_readfirstlane(tid >> 6);
    unsigned char* ws = P.ws;
    const float* norm_a = P.in[8]; const float* w_in_a = P.in[9]; const float* b_gates = P.in[10]; const float* hnorm_a = P.in[11]; const float* w_out_a = P.in[12];
    const float* norm_kv = P.in[13]; const float* w_kv = P.in[14]; const float* norm_b = P.in[16]; const float* w_in_b = P.in[17]; const float* w_out_b = P.in[20];
    LAS float* WG = (LAS float*)(lds + 98304);
    for (int i = tid; i < 8 * 1024; i += NTHR) { const int k = i >> 3, g = i & 7; WG[g * 1024 + k] = w_in_a[(size_t)k * WIN_LD + NP1 + g] * norm_a[k]; }
    LAS float* scr = (LAS float*)(lds + wave * 8704);
    const int gw = vcu * 8 + wave, NGW = G * 8;
    constexpr int I_A = 16 * 320, I_OA = 32 * 32, I_2 = 16 * 160, I_OB = 8 * 32, NIT = I_A + I_OA + I_2 + I_OB;
    for (int it = gw; it < NIT; it += NGW) {
        int r = it;
        if (r < I_A) { const int kb = r / 320, nb = r % 320, n0 = 32 * nb; const float cs = (n0 >= 2048 && n0 < 4096) ? 0.04419417382415922f : 1.0f;
            { const int unit = n0 >> 8, l0 = n0 & 255, wc = l0 >> 6, bj = (l0 >> 5) & 1; const int drow = unit * 256 + 128 * bj + 32 * wc;
              p0_tr_item(w_in_a, WIN_LD, n0, 1024, norm_a, cs, (bf16*)(ws + WS_WA), drow, scr, kb, lane); } continue; } r -= I_A;
        if (r < I_OA) { const int kb = r / 32, nb = r % 32; p0_tr_item(w_out_a, 1024, 32 * nb, 2048, hnorm_a, 1.0f, (bf16*)(ws + WS_WOA), 32 * nb, scr, kb, lane); continue; } r -= I_OA;
        if (r < I_2) { const int kb = r / 160, nb = r % 160, n0 = 32 * nb; const int unit = n0 >> 8, l0 = n0 & 255, wc = l0 >> 6, bj = (l0 >> 5) & 1; const int drow = unit * 256 + 128 * bj + 32 * wc;
            if (n0 < 3072) p0_tr_item(w_kv, 3072, n0, 1024, norm_kv, 1.0f, (bf16*)(ws + WS_W2), drow, scr, kb, lane);
            else p0_tr_item(w_in_b, 2048, n0 - 3072, 1024, norm_b, 1.0f, (bf16*)(ws + WS_W2), drow, scr, kb, lane);
            continue; } r -= I_2;
        { const int kb = r / 32, nb = r % 32; p0_tr_item(w_out_b, 1024, 32 * nb, 512, nullptr, 1.0f, (bf16*)(ws + WS_WOB), 32 * nb, scr, kb, lane); }
    }
    __syncthreads();
    bf16* XN = (bf16*)(ws + WS_XN); float* GATES = (float*)(ws + WS_GATES);
    f32x4 nx[2][4];
    auto rowload = [&](int mA, f32x4 (&dst)[2][4]) {
#pragma unroll
        for (int u = 0; u < 2; ++u) { int m = mA + u * NGW; if (m >= M) m = mA;
            const float* xrow = (m < TP) ? (P.in[0] + (size_t)m * D) : (P.in[1] + (size_t)(m - TP) * D);
            const f32x4* xr = (const f32x4*)xrow + lane;
#pragma unroll
            for (int j = 0; j < 4; ++j) dst[u][j] = xr[64 * j]; } };
    if (gw < M) rowload(gw, nx);
    for (int m0 = gw; m0 < M; m0 += 2 * NGW) {
        const int m1 = m0 + NGW; const bool has1 = m1 < M;
        f32x4 v[2][4]; float s[2] = {0.f, 0.f};
#pragma unroll
        for (int u = 0; u < 2; ++u)
#pragma unroll
            for (int j = 0; j < 4; ++j) v[u][j] = nx[u][j];
        if (m0 + 2 * NGW < M) rowload(m0 + 2 * NGW, nx);
#pragma unroll
        for (int u = 0; u < 2; ++u)
#pragma unroll
            for (int j = 0; j < 4; ++j) s[u] += (v[u][j][0] * v[u][j][0] + v[u][j][1] * v[u][j][1]) + (v[u][j][2] * v[u][j][2] + v[u][j][3] * v[u][j][3]);
        float ga[2][8];
#pragma unroll
        for (int g = 0; g < 8; ++g) {
#pragma unroll
            for (int u = 0; u < 2; ++u) ga[u][g] = 0.f;
#pragma unroll
            for (int j = 0; j < 4; ++j) { const f32x4 w = *(const LAS f32x4*)(WG + g * 1024 + 4 * lane + 256 * j);
#pragma unroll
                for (int u = 0; u < 2; ++u) ga[u][g] += (v[u][j][0] * w[0] + v[u][j][1] * w[1]) + (v[u][j][2] * w[2] + v[u][j][3] * w[3]); } }
#pragma unroll
        for (int o = 1; o < 16; o <<= 1) {
#pragma unroll
            for (int u = 0; u < 2; ++u) { s[u] += __shfl_xor(s[u], o);
#pragma unroll
                for (int g = 0; g < 8; ++g) ga[u][g] += __shfl_xor(ga[u][g], o); } }
#pragma unroll
        for (int u = 0; u < 2; ++u) { s[u] = xsum32(xsum16(s[u]));
#pragma unroll
            for (int g = 0; g < 8; ++g) ga[u][g] = xsum32(xsum16(ga[u][g])); }
#pragma unroll
        for (int u = 0; u < 2; ++u) { if (u == 1 && !has1) break; const int m = u ? m1 : m0;
            const float rnm = sqrtf(s[u] * (1.0f / D) + EPS); const float rstd = 1.0f / rnm;
            if (lane == 0) ((float*)(ws + WS_RNORM))[m] = rnm;
            unsigned long long* o8 = (unsigned long long*)(XN + (size_t)m * D) + lane;
#pragma unroll
            for (int j = 0; j < 4; ++j) o8[64 * j] = (unsigned long long)pk2(v[u][j][0] * rstd, v[u][j][1] * rstd) | ((unsigned long long)pk2(v[u][j][2] * rstd, v[u][j][3] * rstd) << 32);
            if (lane < 8) { float val = 0.f;
#pragma unroll
                for (int g = 0; g < 8; ++g) val = (lane == g) ? ga[u][g] : val;
                val = val * rstd + b_gates[lane];
                if (lane >= 4) val = fminf(val, 0.f) - log1pf(__expf(-fabsf(val)));
                GATES[(size_t)m * 8 + lane] = val; } }
    }
}

namespace scan {
#define TR4(r0, r1, r2, r3, base, o0, o1, o2, o3) asm volatile( \
    "ds_read_b64_tr_b16 %0, %4 offset:%5\n\tds_read_b64_tr_b16 %1, %4 offset:%6\n\tds_read_b64_tr_b16 %2, %4 offset:%7\n\tds_read_b64_tr_b16 %3, %4 offset:%8\n\ts_waitcnt lgkmcnt(0)" \
    : "=&v"(r0), "=&v"(r1), "=&v"(r2), "=&v"(r3) : "v"(base), "i"(o0), "i"(o1), "i"(o2), "i"(o3) : "memory")

DI bf16x8 cat8(s16x4 lo, s16x4 hi) { return __builtin_shufflevector(lo, hi, 0, 1, 2, 3, 4, 5, 6, 7); }

}
namespace scan2 {
constexpr int RING = 0;
constexpr int VSB = 98304;
constexpr int PS = 114688;
constexpr int SCAL = 122880;
constexpr int RS = 131072;
constexpr int QN = 131584;
constexpr int NVEC = 131840;
constexpr int NBF = 133888;
constexpr int LEND = 135936;
constexpr int ATILE = 136192;
constexpr int SSQ = 144384;
constexpr int LEND2 = 145408;
constexpr int OT = 145408, ZT = 153600;
constexpr int LEND3 = 161792;
static_assert(LEND3 <= LDS_BYTES - 32 && LEND + 16 <= ATILE, "scan2 LDS map");


#define SC2_STORE_TILE(cprev) do { if (!DRY) { const size_t rb_ = rowb + (size_t)(cprev) * 64; \
        _Pragma("unroll") for (int i_ = 0; i_ < 2; ++i_) { const int t_ = 16 * wave + (lane >> 3) + 8 * i_, k_ = lane & 7; \
            v4u v_ = *(const LAS v4u*)(lds + ATILE + t_ * 128 + ((k_ ^ ((t_ & 15) >> 1)) << 4)); if (t_ & 1) v_ = (v4u){v_.z, v_.w, v_.x, v_.y}; \
            *(v4u*)(A3 + (rb_ + t_) * DI_ + h * 512 + es * 64 + 8 * k_) = v_; } \
        if (lane < 16) { const int t_ = 16 * wave + lane; const LAS float* sq_ = (const LAS float*)(lds + SSQ); \
            HSS[(rb_ + t_) * 32 + h * 8 + es] = (sq_[t_] + sq_[64 + t_]) + (sq_[128 + t_] + sq_[192 + t_]); } } } while (0)
#ifndef SC2_NOPIN
#define SC2_W() do { asm volatile("s_waitcnt lgkmcnt(0)" ::: "memory"); __builtin_amdgcn_sched_barrier(0); } while (0)
#define SC2_SB() __builtin_amdgcn_sched_barrier(0)
#else
#define SC2_W() do {} while (0)
#define SC2_SB() do {} while (0)
#endif
DI int fsw(int r) { return ((r & 3) << 1) | ((r >> 2) & 1) | (r & 8); }
DI bf16x8 cat8(s16x4 lo, s16x4 hi) { return __builtin_shufflevector(lo, hi, 0, 1, 2, 3, 4, 5, 6, 7); }
#define SC2_BAR() do { asm volatile("" ::: "memory"); __builtin_amdgcn_s_barrier(); asm volatile("" ::: "memory"); } while (0)
#define TR2(r0, r1, base, o0, o1) asm volatile("ds_read_b64_tr_b16 %0, %2 offset:%3\n\tds_read_b64_tr_b16 %1, %2 offset:%4\n\ts_waitcnt lgkmcnt(0)" \
    : "=&v"(r0), "=&v"(r1) : "v"(base), "i"(o0), "i"(o1) : "memory")
#define TR8(r0, r1, r2, r3, r4, r5, r6, r7, b0, b1, b2, b3, o0, o1) asm volatile( \
    "ds_read_b64_tr_b16 %0, %8 offset:%12\n\tds_read_b64_tr_b16 %1, %8 offset:%13\n\tds_read_b64_tr_b16 %2, %9 offset:%12\n\tds_read_b64_tr_b16 %3, %9 offset:%13\n\t" \
    "ds_read_b64_tr_b16 %4, %10 offset:%12\n\tds_read_b64_tr_b16 %5, %10 offset:%13\n\tds_read_b64_tr_b16 %6, %11 offset:%12\n\tds_read_b64_tr_b16 %7, %11 offset:%13\n\ts_waitcnt lgkmcnt(0)" \
    : "=&v"(r0), "=&v"(r1), "=&v"(r2), "=&v"(r3), "=&v"(r4), "=&v"(r5), "=&v"(r6), "=&v"(r7) : "v"(b0), "v"(b1), "v"(b2), "v"(b3), "i"(o0), "i"(o1) : "memory")

#define TR8N(r0, r1, r2, r3, r4, r5, r6, r7, b0, b1, b2, b3, o0, o1) asm volatile( \
    "ds_read_b64_tr_b16 %0, %8 offset:%12\n\tds_read_b64_tr_b16 %1, %8 offset:%13\n\tds_read_b64_tr_b16 %2, %9 offset:%12\n\tds_read_b64_tr_b16 %3, %9 offset:%13\n\t" \
    "ds_read_b64_tr_b16 %4, %10 offset:%12\n\tds_read_b64_tr_b16 %5, %10 offset:%13\n\tds_read_b64_tr_b16 %6, %11 offset:%12\n\tds_read_b64_tr_b16 %7, %11 offset:%13" \
    : "=&v"(r0), "=&v"(r1), "=&v"(r2), "=&v"(r3), "=&v"(r4), "=&v"(r5), "=&v"(r6), "=&v"(r7) : "v"(b0), "v"(b1), "v"(b2), "v"(b3), "i"(o0), "i"(o1) : "memory")
#define WAIT8(r0, r1, r2, r3, r4, r5, r6, r7) do { asm volatile("s_waitcnt lgkmcnt(0)" : "+v"(r0), "+v"(r1), "+v"(r2), "+v"(r3), "+v"(r4), "+v"(r5), "+v"(r6), "+v"(r7) :: "memory"); __builtin_amdgcn_sched_barrier(0); } while (0)
template <int MODE>
DI void prompt_scan(const Params& P, LAS unsigned char* lds, int item, int wv) {
    constexpr bool DRY = MODE != 0, NO_C = MODE == 2 || MODE == 5 || MODE >= 6, NO_LOAD = MODE == 3 || MODE >= 8, NO_S = MODE == 4 || MODE == 2 || MODE >= 6, NO_EPI = MODE == 8;
    int tid_ = (wv << 6) | lane_id(); asm volatile("" : "+v"(tid_)); const int tid = tid_, lane = tid & 63, wave = __builtin_amdgcn_readfirstlane(tid >> 6);
    const int pair = (item & 7) * 4 + (item >> 6), es = (item >> 3) & 7;
    const int b = pair >> 2, h = pair & 3;
    const int qpair = (MODE == 7) ? 0 : ((MODE == 6) ? ((b * 4 + h + es * 4) & 31) : (b * 4 + h));
    unsigned char* ws = P.ws; float* out = P.out;
    const bf16* P1 = (const bf16*)(ws + WS_P1); const float* GATES = (const float*)(ws + WS_GATES);
    float* SCG = (float*)(ws + WS_SCALG) + (size_t)item * 64 * 1024;
    bf16* A3 = (bf16*)(ws + WS_A3); float* HSS = (float*)(ws + WS_HSS);
    const size_t rowb = (size_t)b * SEQ;
    const unsigned lbase = (unsigned)(uintptr_t)lds;

    __syncthreads();
    for (int i = tid; i < (LEND - PS) / 16; i += NTHR) *(LAS v4u*)(lds + PS + i * 16) = (v4u){0u, 0u, 0u, 0u};
    float m_final;
    {
        LAS float* TG = (LAS float*)(lds + 0); LAS float* TM = (LAS float*)(lds + 16384); LAS float* TMP = (LAS float*)(lds + 32768);
        float lf[8], ig[8];
#pragma unroll
        for (int k = 0; k < 8; ++k) { const float* gp = GATES + (rowb + tid * 8 + k) * 8; ig[k] = gp[h]; lf[k] = gp[4 + h]; }
        float g[8]; float run = 0.f;
#pragma unroll
        for (int k = 0; k < 8; ++k) { run += lf[k]; g[k] = run; }
        float x = run;
#pragma unroll
        for (int o = 1; o < 64; o <<= 1) { const float y = __shfl_up(x, o); if (lane >= o) x += y; }
        if (lane == 63) TMP[wave] = x;
        __syncthreads();
        float woff = 0.f;
        for (int w = 0; w < wave; ++w) woff += TMP[w];
        const float off = woff + x - run;
        float a[8]; float cm = -INFINITY;
#pragma unroll
        for (int k = 0; k < 8; ++k) { g[k] += off; cm = fmaxf(cm, ig[k] - g[k]); a[k] = cm; }
        float y = cm;
#pragma unroll
        for (int o = 1; o < 64; o <<= 1) { const float z = __shfl_up(y, o); if (lane >= o) y = fmaxf(y, z); }
        if (lane == 63) TMP[8 + wave] = y;
        __syncthreads();
        float pm = -INFINITY;
        for (int w = 0; w < wave; ++w) pm = fmaxf(pm, TMP[8 + w]);
        const float yprev = __shfl_up(y, 1); if (lane > 0) pm = fmaxf(pm, yprev);
        float mm[8];
#pragma unroll
        for (int k = 0; k < 8; ++k) { mm[k] = g[k] + fmaxf(0.f, fmaxf(pm, a[k])); TG[tid * 8 + k] = g[k]; TM[tid * 8 + k] = mm[k]; }
        __syncthreads();
        const int c = tid >> 3, t0 = c * 64;
        const float Gp = (c > 0) ? TG[t0 - 1] : 0.f, Mp = (c > 0) ? TM[t0 - 1] : 0.f, Gl = TG[t0 + 63], Ml = TM[t0 + 63];
        float* sc = SCG + (size_t)c * 1024;
#pragma unroll
        for (int k = 0; k < 8; ++k) { const int i = (tid & 7) * 8 + k;
            sc[i] = g[k] - mm[k]; sc[64 + i] = g[k] - ig[k]; sc[128 + i] = __expf(g[k] - Gp + Mp - mm[k]); sc[192 + i] = __expf(Gl - g[k] + ig[k] - Ml); sc[256 + i] = __expf(-mm[k]); }
        if ((tid & 7) == 0) sc[320] = __expf(Gl - Gp + Mp - Ml);
        m_final = TM[4095];
        if (tid == 0) *(LAS float*)(lds + LEND) = m_final;
        VM_WAIT();
        __syncthreads();
    }

#define SC2_GEOM() const int ln_ = lane_id(); const int x15 = ln_ & 15, g4 = ln_ >> 4, q4 = (ln_ & 15) >> 2, p4 = ln_ & 3, r31 = ln_ & 31, hh = ln_ >> 5; const int fx = fsw(x15); \
    unsigned ktrow[2]; int ktbase[2]; \
    _Pragma("unroll") for (int r2 = 0; r2 < 2; ++r2) { const int s15 = (8 * (g4 & 1) + q4 + 4 * r2) & 15; ktrow[r2] = (unsigned)((8 * g4 + q4 + 4 * r2) * 256 + 8 * (p4 & 1)); ktbase[r2] = (p4 >> 1) ^ fsw(s15); } \
    (void)r31; (void)hh; (void)fx; (void)ktrow; (void)ktbase; (void)x15;
    if (wave < 4) {
        const int e0 = 16 * wave;
        f32x4 C[32]; f32x4 Y[4];
#pragma unroll
        for (int i = 0; i < 32; ++i) C[i] = (f32x4){0.f, 0.f, 0.f, 0.f};
#pragma unroll
        for (int i = 0; i < 4; ++i) Y[i] = (f32x4){0.f, 0.f, 0.f, 0.f};
        bf16x8 Bw[2];
        SC2_BAR();
        int slot = 0;
        for (int c = 0; c <= 64; ++c) {
            SC2_GEOM();
            const unsigned vfb = lbase + (unsigned)((8 * g4 + q4) * 128 + (e0 + 4 * p4) * 2);
            const size_t row0 = rowb + (size_t)(c - 1) * 64;
#pragma unroll
            for (int j = 0; j < 4; ++j) {
                if (j == 0 && !NO_EPI) {
                    if (c > 0) {
                        const LAS float* SCL = (const LAS float*)(lds + SCAL) + ((c - 1) & 1) * 1024;
                        const LAS float* RSp = (const LAS float*)(lds + RS); const LAS float* QNp = (const LAS float*)(lds + QN);
                        s16x4 vf[2][2];
                        { const unsigned vb = vfb + VSB + ((c - 1) & 1) * 8192;
                          asm volatile("ds_read_b64_tr_b16 %0, %4\n\tds_read_b64_tr_b16 %1, %4 offset:512\n\tds_read_b64_tr_b16 %2, %4 offset:4096\n\tds_read_b64_tr_b16 %3, %4 offset:4608"
                                       : "=&v"(vf[0][0]), "=&v"(vf[0][1]), "=&v"(vf[1][0]), "=&v"(vf[1][1]) : "v"(vb) : "memory"); }
#pragma unroll
                        for (int half = 0; half < 2; ++half) {
                            v2u ov[2], zv[2]; bf16x8 Bp[2][2]; float s_in[2], s_en[2], s_r0[2], s_r1[2], s_qn[2];
#pragma unroll
                            for (int u = 0; u < 2; ++u) { const int t = 16 * (2 * half + u) + x15; const int lo_ = t * 128 + (((2 * wave + (g4 >> 1)) ^ (t & 7)) << 4) + 8 * (g4 & 1);
                                ov[u] = *(const LAS v2u*)(lds + OT + lo_); zv[u] = *(const LAS v2u*)(lds + ZT + lo_);
#pragma unroll
                                for (int ks2 = 0; ks2 < 2; ++ks2) Bp[u][ks2] = *(const LAS bf16x8*)(lds + PS + t * 128 + (((4 * ks2 + g4) ^ (t & 7)) << 4));
                                s_in[u] = SCL[128 + t]; s_en[u] = SCL[256 + t]; s_r0[u] = RSp[t]; s_r1[u] = RSp[64 + t]; s_qn[u] = QNp[t]; }
                            asm volatile("s_waitcnt lgkmcnt(0)" : "+v"(vf[0][0]), "+v"(vf[0][1]), "+v"(vf[1][0]), "+v"(vf[1][1]) :: "memory");
                            __builtin_amdgcn_sched_barrier(0);
                            f32x4 Yi[2];
#pragma unroll
                            for (int u = 0; u < 2; ++u) { Yi[u] = (f32x4){0.f, 0.f, 0.f, 0.f};
#pragma unroll
                                for (int ks2 = 0; ks2 < 2; ++ks2) Yi[u] = MFMA16(cat8(vf[ks2][0], vf[ks2][1]), Bp[u][ks2], Yi[u]); }
#pragma unroll
                            for (int u = 0; u < 2; ++u) { const int tt = 2 * half + u, t = 16 * tt + x15;
                                const float inter = s_in[u];
                                const float den = s_r0[u] + s_r1[u] + inter * s_qn[u];
                                const float rden = __builtin_amdgcn_rcpf(fmaxf(fabsf(den), s_en[u]));
                                float hv[4]; float ssq = 0.f;
#pragma unroll
                                for (int r = 0; r < 4; ++r) { hv[r] = (Yi[u][r] + inter * Y[tt][r]) * rden; ssq += hv[r] * hv[r]; }
                                const float o0 = bf_lo(ov[u].x), o1 = bf_hi(ov[u].x), o2 = bf_lo(ov[u].y), o3 = bf_hi(ov[u].y);
                                const float z0 = bf_lo(zv[u].x), z1 = bf_hi(zv[u].x), z2 = bf_lo(zv[u].y), z3 = bf_hi(zv[u].y);
                                v2u w; w.x = pk2(hv[0] * fgate(o0, z0), hv[1] * fgate(o1, z1));
                                w.y = pk2(hv[2] * fgate(o2, z2), hv[3] * fgate(o3, z3));
                                *(LAS v2u*)(lds + ATILE + t * 128 + (((4 * wave + g4) ^ (t & 15)) << 3)) = w;
                                ssq = xsum32(xsum16(ssq));
                                if (g4 == 0) ((LAS float*)(lds + SSQ))[wave * 64 + t] = ssq;
                                Y[tt] = (f32x4){0.f, 0.f, 0.f, 0.f}; }
                        }
                    }
                    if (c < 64) {
                        const LAS float* SCL = (const LAS float*)(lds + SCAL) + (c & 1) * 1024;
                        s16x4 vf[2][2]; f32x4 wq[2][2];
                        { const unsigned vb = vfb + VSB + (c & 1) * 8192;
                          asm volatile("ds_read_b64_tr_b16 %0, %4\n\tds_read_b64_tr_b16 %1, %4 offset:512\n\tds_read_b64_tr_b16 %2, %4 offset:4096\n\tds_read_b64_tr_b16 %3, %4 offset:4608"
                                       : "=&v"(vf[0][0]), "=&v"(vf[0][1]), "=&v"(vf[1][0]), "=&v"(vf[1][1]) : "v"(vb) : "memory"); }
#pragma unroll
                        for (int ks2 = 0; ks2 < 2; ++ks2) { wq[ks2][0] = *(const LAS f32x4*)(SCL + 192 + 32 * ks2 + 8 * g4); wq[ks2][1] = *(const LAS f32x4*)(SCL + 192 + 32 * ks2 + 8 * g4 + 4); }
                        asm volatile("s_waitcnt lgkmcnt(0)" : "+v"(vf[0][0]), "+v"(vf[0][1]), "+v"(vf[1][0]), "+v"(vf[1][1]) :: "memory");
                        __builtin_amdgcn_sched_barrier(0);
#pragma unroll
                        for (int ks2 = 0; ks2 < 2; ++ks2) { const f32x4 w0 = wq[ks2][0], w1 = wq[ks2][1];
                            const v4u raw = __builtin_bit_cast(v4u, cat8(vf[ks2][0], vf[ks2][1])); v4u o;
                            o.x = pk2(bf_lo(raw.x) * w0[0], bf_hi(raw.x) * w0[1]); o.y = pk2(bf_lo(raw.y) * w0[2], bf_hi(raw.y) * w0[3]);
                            o.z = pk2(bf_lo(raw.z) * w1[0], bf_hi(raw.z) * w1[1]); o.w = pk2(bf_lo(raw.w) * w1[2], bf_hi(raw.w) * w1[3]);
                            Bw[ks2] = __builtin_bit_cast(bf16x8, o); }
                    }
                }
                if (j == 1 && c > 0) SC2_STORE_TILE(c - 1);
                if (c < 64 && !NO_C) {
                    const LAS unsigned char* QSL = lds + RING + slot * 32768; const unsigned ksl = lbase + RING + slot * 32768 + 16384;
                    const float decay = ((const LAS float*)(lds + SCAL))[(c & 1) * 1024 + 320];
#pragma unroll
                    for (int kb = 0; kb < 2; ++kb) {
                        s16x4 lo[2][4], hi[2][4];
                        { const unsigned qb_ = lbase + RING + slot * 32768 + (unsigned)(x15 * 256 + 8 * (g4 & 1));
#pragma unroll
                          for (int k2 = 0; k2 < 2; ++k2) { const int ks = 2 * kb + k2;
                            const unsigned bl_ = qb_ + (unsigned)(((4 * ks + (g4 >> 1)) ^ fx) << 4), bh_ = qb_ + (unsigned)(((4 * ks + 2 + (g4 >> 1)) ^ fx) << 4);
                            asm volatile("ds_read_b64 %0, %8\n\tds_read_b64 %1, %8 offset:4096\n\tds_read_b64 %2, %8 offset:8192\n\tds_read_b64 %3, %8 offset:12288\n\t"
                                         "ds_read_b64 %4, %9\n\tds_read_b64 %5, %9 offset:4096\n\tds_read_b64 %6, %9 offset:8192\n\tds_read_b64 %7, %9 offset:12288"
                                         : "=&v"(lo[k2][0]), "=&v"(lo[k2][1]), "=&v"(lo[k2][2]), "=&v"(lo[k2][3]), "=&v"(hi[k2][0]), "=&v"(hi[k2][1]), "=&v"(hi[k2][2]), "=&v"(hi[k2][3]) : "v"(bl_), "v"(bh_) : "memory"); } }
                        bf16x8 A[2];
#pragma unroll
                        for (int k2 = 0; k2 < 2; ++k2) { const int ks = 2 * kb + k2; const f32x4 c0 = C[8 * j + 2 * ks], c1 = C[8 * j + 2 * ks + 1];
                            v4u ap; ap.x = pk2(c0[0], c0[1]); ap.y = pk2(c0[2], c0[3]); ap.z = pk2(c1[0], c1[1]); ap.w = pk2(c1[2], c1[3]); A[k2] = __builtin_bit_cast(bf16x8, ap); }
                        asm volatile("s_waitcnt lgkmcnt(0)" : "+v"(lo[0][0]), "+v"(lo[0][1]), "+v"(lo[0][2]), "+v"(lo[0][3]), "+v"(hi[0][0]), "+v"(hi[0][1]), "+v"(hi[0][2]), "+v"(hi[0][3]),
                                     "+v"(lo[1][0]), "+v"(lo[1][1]), "+v"(lo[1][2]), "+v"(lo[1][3]), "+v"(hi[1][0]), "+v"(hi[1][1]), "+v"(hi[1][2]), "+v"(hi[1][3]) :: "memory");
                        __builtin_amdgcn_sched_barrier(0);
#pragma unroll
                        for (int k2 = 0; k2 < 2; ++k2)
#pragma unroll
                            for (int tt = 0; tt < 4; ++tt) Y[tt] = MFMA16(A[k2], cat8(lo[k2][tt], hi[k2][tt]), Y[tt]);
                        SC2_SB();
                    }
#pragma unroll
                    for (int dq = 0; dq < 2; ++dq) {
                        s16x4 ka[2][2][2][2];
#pragma unroll
                        for (int u = 0; u < 2; ++u) { const int dp = 2 * dq + u;
                            const unsigned b00 = ksl + ktrow[0] + (unsigned)(((ktbase[0]) ^ (2 * (2 * dp))) << 4), b01 = ksl + ktrow[1] + (unsigned)(((ktbase[1]) ^ (2 * (2 * dp))) << 4);
                            const unsigned b10 = ksl + ktrow[0] + (unsigned)(((ktbase[0]) ^ (2 * (2 * dp + 1))) << 4), b11 = ksl + ktrow[1] + (unsigned)(((ktbase[1]) ^ (2 * (2 * dp + 1))) << 4);
                            TR8N(ka[u][0][0][0], ka[u][0][0][1], ka[u][0][1][0], ka[u][0][1][1], ka[u][1][0][0], ka[u][1][0][1], ka[u][1][1][0], ka[u][1][1][1], b00, b01, b10, b11, 0, 8192); }
                        asm volatile("s_waitcnt lgkmcnt(0)" : "+v"(ka[0][0][0][0]), "+v"(ka[0][0][0][1]), "+v"(ka[0][0][1][0]), "+v"(ka[0][0][1][1]), "+v"(ka[0][1][0][0]), "+v"(ka[0][1][0][1]), "+v"(ka[0][1][1][0]), "+v"(ka[0][1][1][1]),
                                     "+v"(ka[1][0][0][0]), "+v"(ka[1][0][0][1]), "+v"(ka[1][0][1][0]), "+v"(ka[1][0][1][1]), "+v"(ka[1][1][0][0]), "+v"(ka[1][1][0][1]), "+v"(ka[1][1][1][0]), "+v"(ka[1][1][1][1]) :: "memory");
                        __builtin_amdgcn_sched_barrier(0);
#pragma unroll
                        for (int u = 0; u < 2; ++u)
#pragma unroll
                            for (int d2 = 0; d2 < 2; ++d2) { const int T = 8 * j + 2 * (2 * dq + u) + d2; f32x4 cc = C[T] * decay;
#pragma unroll
                                for (int ks2 = 0; ks2 < 2; ++ks2) cc = MFMA16(cat8(ka[u][d2][0][ks2], ka[u][d2][1][ks2]), Bw[ks2], cc);
                                C[T] = cc; }
                    }
                }
                asm volatile("s_waitcnt lgkmcnt(0)" ::: "memory");
                SC2_BAR();
                slot = (slot == 2) ? 0 : slot + 1;
                if (c == 64) break;
            }
        }
        SC2_STORE_TILE(63);
        { int ln2 = lane; asm volatile("" : "+v"(ln2)); const int xo = ln2 & 15, go = ln2 >> 4;
          float* cp = out + O_CP + ((size_t)(b * NH + h) * DH + 4 * go) * DH + es * 64 + e0 + xo;
#pragma unroll
        for (int T = 0; T < 32; ++T)
#pragma unroll
            for (int r = 0; r < 4; ++r) { if (!DRY) cp[(size_t)(16 * T + r) * DH] = C[T][r]; else asm volatile("" :: "v"(C[T][r])); } }
    } else {
        const int sw = wave - 4;
        const int tt = (sw == 0) ? 0 : 1, st = (sw == 2) ? 1 : 0;
        f32x16 Racc; bf16x8 Bwn[2];
#pragma unroll
        for (int r = 0; r < 16; ++r) Racc[r] = 0.f;
        Bwn[0] = Bwn[1] = (bf16x8){0, 0, 0, 0, 0, 0, 0, 0};
        unsigned srcq[4]; unsigned srcv[2]; unsigned srco[2];
        { const int x15 = lane & 15, g4 = lane >> 4;
#pragma unroll
        for (int i = 0; i < 4; ++i) { const int row = 4 * (4 * sw + i) + g4; srcq[i] = (unsigned)(row * 128 + 8 * (x15 ^ fsw(row & 15))); }
#pragma unroll
        for (int i = 0; i < 2; ++i) { const int row = 8 * (2 * sw + i) + (lane >> 3); srco[i] = (unsigned)(row * 64 + 8 * ((lane & 7) ^ (row & 7))); }
#pragma unroll
        for (int i = 0; i < 2; ++i) srcv[i] = (unsigned)(512 * (2 * sw + i) + 8 * lane);
        }
#define SC2_GLDS(src, dstoff) __builtin_amdgcn_global_load_lds((const unsigned*)(src), (LAS unsigned*)(lds + (dstoff)), 16, 0, 0)
#define SC2_ISSUE_SLAB(gidx, slt) do { const int g_ = (gidx) < 255 ? (gidx) : 255; const bf16* qb = P1 + ((size_t)g_ * 32 + qpair) * 16384; const bf16* kb = qb + 8192; \
        _Pragma("unroll") for (int i_ = 0; i_ < 4; ++i_) { SC2_GLDS(qb + srcq[i_], RING + (slt) * 32768 + 1024 * (4 * sw + i_)); SC2_GLDS(kb + srcq[i_], RING + (slt) * 32768 + 16384 + 1024 * (4 * sw + i_)); } } while (0)
#define SC2_ISSUE_VS(cidx) do { const int c_ = (cidx) < 63 ? (cidx) : 63; const bf16* vb_ = P1 + P1_V + (((size_t)c_ * 32 + (b * 4 + h)) * 8 + es) * 4096; \
        _Pragma("unroll") for (int i_ = 0; i_ < 2; ++i_) SC2_GLDS(vb_ + srcv[i_], VSB + ((cidx) & 1) * 8192 + 1024 * (2 * sw + i_)); \
        SC2_GLDS(SCG + (size_t)c_ * 1024 + 256 * sw + 4 * lane, SCAL + ((cidx) & 1) * 4096 + 1024 * sw); } while (0)
#define SC2_ISSUE_OZ(cidx) do { const bf16* ob_ = P1 + P1_V + P1_PART + (((size_t)(cidx) * 32 + (b * 4 + h)) * 8 + es) * 4096; \
        _Pragma("unroll") for (int i_ = 0; i_ < 2; ++i_) { SC2_GLDS(ob_ + srco[i_], OT + 1024 * (2 * sw + i_)); SC2_GLDS(ob_ + P1_PART + srco[i_], ZT + 1024 * (2 * sw + i_)); } } while (0)
        SC2_ISSUE_VS(0);
        SC2_ISSUE_SLAB(0, 0);
        SC2_ISSUE_SLAB(1, 1);
        asm volatile("s_waitcnt vmcnt(8) lgkmcnt(0)" ::: "memory");
        SC2_BAR();
        int slot = 0;
        for (int c = 0; c <= 64; ++c) {
            SC2_GEOM();
            const LAS float* SCL = (const LAS float*)(lds + SCAL) + (c & 1) * 1024;
#pragma unroll
            for (int j = 0; j < 4; ++j) {
                if (c < 64) {
                    const int s2 = (slot == 0) ? 2 : slot - 1;
                    if (!NO_LOAD) { SC2_ISSUE_SLAB(4 * c + j + 2, s2);
                    if (j == 1) SC2_ISSUE_VS(c + 1);
                    if (j == 2) SC2_ISSUE_OZ(c); }
                    const LAS unsigned char* QSL = lds + RING + slot * 32768; const LAS unsigned char* KSL = QSL + 16384;
                    if (!NO_S) {
                    if (sw < 3) {
                        const int ra = 32 * st + r31, rb = 32 * tt + r31;
                        { bf16x8 Af[8], Bf[8];
#pragma unroll
                            for (int ks = 0; ks < 8; ++ks) { Af[ks] = *(const LAS bf16x8*)(KSL + ra * 256 + (((2 * ks + hh) ^ fx) << 4)); Bf[ks] = *(const LAS bf16x8*)(QSL + rb * 256 + (((2 * ks + hh) ^ fx) << 4)); }
                            SC2_W();
#pragma unroll
                            for (int ks = 0; ks < 8; ++ks) Racc = MFMA32(Af[ks], Bf[ks], Racc);
                            SC2_SB(); }
                    } else {
                        f32x4 qa[4];
#pragma unroll
                        for (int t16 = 0; t16 < 4; ++t16) qa[t16] = (f32x4){Racc[4 * t16], Racc[4 * t16 + 1], Racc[4 * t16 + 2], Racc[4 * t16 + 3]};
                        { bf16x8 Bn[4], Aq[4][4];
#pragma unroll
                            for (int ks = 0; ks < 4; ++ks) { Bn[ks] = *(const LAS bf16x8*)(lds + NBF + (c & 1) * 1024 + (128 * j + 32 * ks + 8 * g4) * 2);
#pragma unroll
                                for (int t16 = 0; t16 < 4; ++t16) Aq[ks][t16] = *(const LAS bf16x8*)(QSL + (16 * t16 + x15) * 256 + (((4 * ks + g4) ^ fx) << 4)); }
                            SC2_W();
#pragma unroll
                            for (int ks = 0; ks < 4; ++ks) { if (x15 != 0) Bn[ks] = (bf16x8){0, 0, 0, 0, 0, 0, 0, 0};
#pragma unroll
                                for (int t16 = 0; t16 < 4; ++t16) qa[t16] = MFMA16(Aq[ks][t16], Bn[ks], qa[t16]); }
                            SC2_SB(); }
#pragma unroll
                        for (int t16 = 0; t16 < 4; ++t16) { Racc[4 * t16] = qa[t16][0]; Racc[4 * t16 + 1] = qa[t16][1]; Racc[4 * t16 + 2] = qa[t16][2]; Racc[4 * t16 + 3] = qa[t16][3]; }
                    }
#ifndef SC2_OLDN
                    { const unsigned ksl = lbase + RING + slot * 32768 + 16384;
                      s16x4 ka[2][2][2]; f32x4 wq[2][2]; f32x4 nvo[2];
                      LAS float* NV0 = (LAS float*)(lds + NVEC) + 128 * j + 32 * sw + 4 * g4;
                      const unsigned b00 = ksl + ktrow[0] + (unsigned)(((ktbase[0]) ^ (2 * (2 * sw))) << 4), b01 = ksl + ktrow[1] + (unsigned)(((ktbase[1]) ^ (2 * (2 * sw))) << 4);
                      const unsigned b10 = ksl + ktrow[0] + (unsigned)(((ktbase[0]) ^ (2 * (2 * sw + 1))) << 4), b11 = ksl + ktrow[1] + (unsigned)(((ktbase[1]) ^ (2 * (2 * sw + 1))) << 4);
                      TR8N(ka[0][0][0], ka[0][0][1], ka[0][1][0], ka[0][1][1], ka[1][0][0], ka[1][0][1], ka[1][1][0], ka[1][1][1], b00, b01, b10, b11, 0, 8192);
                      if (j == 0) {
#pragma unroll
                          for (int ks2 = 0; ks2 < 2; ++ks2) { wq[ks2][0] = *(const LAS f32x4*)(SCL + 192 + 32 * ks2 + 8 * g4); wq[ks2][1] = *(const LAS f32x4*)(SCL + 192 + 32 * ks2 + 8 * g4 + 4); } }
                      nvo[0] = *(const LAS f32x4*)NV0; nvo[1] = *(const LAS f32x4*)(NV0 + 16);
                      const float decay = SCL[320];
                      WAIT8(ka[0][0][0], ka[0][0][1], ka[0][1][0], ka[0][1][1], ka[1][0][0], ka[1][0][1], ka[1][1][0], ka[1][1][1]);
                      if (j == 0) {
#pragma unroll
                          for (int ks2 = 0; ks2 < 2; ++ks2) { const f32x4 w0 = wq[ks2][0], w1 = wq[ks2][1];
                              v4u o = (v4u){pk2(w0[0], w0[1]), pk2(w0[2], w0[3]), pk2(w1[0], w1[1]), pk2(w1[2], w1[3])}; if (x15 != 0) o = (v4u){0u, 0u, 0u, 0u}; Bwn[ks2] = __builtin_bit_cast(bf16x8, o); } }
#pragma unroll
                      for (int d2 = 0; d2 < 2; ++d2) { f32x4 nn = (f32x4){0.f, 0.f, 0.f, 0.f};
#pragma unroll
                          for (int ks2 = 0; ks2 < 2; ++ks2) nn = MFMA16(cat8(ka[d2][0][ks2], ka[d2][1][ks2]), Bwn[ks2], nn);
                          if (x15 == 0) { const int d = 128 * j + 32 * sw + 16 * d2 + 4 * g4; const f32x4 nv = nvo[d2] * decay + nn; *(LAS f32x4*)(NV0 + 16 * d2) = nv;
                              v2u w; w.x = pk2(nv[0], nv[1]); w.y = pk2(nv[2], nv[3]); *(LAS v2u*)(lds + NBF + ((c + 1) & 1) * 1024 + d * 2) = w; } }
                    }
#else
                    { const int dq = ln_ >> 3, sp = ln_ & 7; const int chunk = 4 * sw + (dq >> 1); float a0 = 0.f, a1 = 0.f, a2 = 0.f, a3 = 0.f;
#pragma unroll
                        for (int ss = 0; ss < 8; ++ss) { const int s = 8 * sp + ss; const v2u kv = *(const LAS v2u*)(KSL + s * 256 + ((chunk ^ fsw(s & 15)) << 4) + 8 * (dq & 1)); const float w = SCL[192 + s];
                            a0 += w * bf_lo(kv.x); a1 += w * bf_hi(kv.x); a2 += w * bf_lo(kv.y); a3 += w * bf_hi(kv.y); }
#pragma unroll
                        for (int o = 1; o < 8; o <<= 1) { a0 += __shfl_xor(a0, o); a1 += __shfl_xor(a1, o); a2 += __shfl_xor(a2, o); a3 += __shfl_xor(a3, o); }
                        if (sp == 0) { const int d = 128 * j + 32 * sw + 4 * dq; LAS float* NV = (LAS float*)(lds + NVEC) + d; f32x4 nv = *(LAS f32x4*)NV; nv = nv * SCL[320] + (f32x4){a0, a1, a2, a3}; *(LAS f32x4*)NV = nv;
                            v2u w; w.x = pk2(nv[0], nv[1]); w.y = pk2(nv[2], nv[3]); *(LAS v2u*)(lds + NBF + ((c + 1) & 1) * 1024 + d * 2) = w; } }
#endif
                    if (j == 3) {
                        if (sw < 3) {
                            const int t = 32 * tt + r31; const float At = SCL[t]; float rsum = 0.f;
                            f32x4 Bs[4];
#pragma unroll
                            for (int g = 0; g < 4; ++g) Bs[g] = *(const LAS f32x4*)(SCL + 64 + 32 * st + 8 * g + 4 * hh);
                            SC2_W();
#pragma unroll
                            for (int g = 0; g < 4; ++g) { float pv[4];
#pragma unroll
                                for (int jj = 0; jj < 4; ++jj) { const int s = 32 * st + 8 * g + 4 * hh + jj; const float ev = __builtin_amdgcn_exp2f((At - Bs[g][jj]) * 1.4426950408889634f);
                                    const float dm = (s <= t) ? ev : 0.f; pv[jj] = Racc[4 * g + jj] * dm; rsum += pv[jj]; }
                                v2u w; w.x = pk2(pv[0], pv[1]); w.y = pk2(pv[2], pv[3]);
                                *(LAS v2u*)(lds + PS + t * 128 + (((4 * st + g) ^ (t & 7)) << 4) + 8 * hh) = w; }
                            rsum = xsum32(rsum);
                            if (hh == 0) ((LAS float*)(lds + RS))[st * 64 + t] = rsum;
                        } else if (x15 == 0) {
#pragma unroll
                            for (int t16 = 0; t16 < 4; ++t16)
#pragma unroll
                                for (int r = 0; r < 4; ++r) ((LAS float*)(lds + QN))[16 * t16 + 4 * g4 + r] = Racc[4 * t16 + r];
                        }
#pragma unroll
                        for (int r = 0; r < 16; ++r) Racc[r] = 0.f;
                    }
                    }
                }
                if (c < 64) { if (j == 1) asm volatile("s_waitcnt vmcnt(11) lgkmcnt(0)" ::: "memory"); else if (j == 2) asm volatile("s_waitcnt vmcnt(12) lgkmcnt(0)" ::: "memory"); else asm volatile("s_waitcnt vmcnt(8) lgkmcnt(0)" ::: "memory"); }
                else asm volatile("s_waitcnt vmcnt(0) lgkmcnt(0)" ::: "memory");
                SC2_BAR();
                slot = (slot == 2) ? 0 : slot + 1;
                if (c == 64) break;
            }
        }
    }
    __syncthreads();
    { const int tid2 = (wv << 6) | lane_id();
      if (!DRY && es == 0) { out[O_NP + (size_t)(b * NH + h) * DH + tid2] = ((const LAS float*)(lds + NVEC))[tid2]; if (tid2 == 0) out[O_MP + b * NH + h] = *(const LAS float*)(lds + LEND); } }
    __syncthreads();
}
}

namespace sscan {
constexpr int QT = 0;
constexpr int KT = 16384;
constexpr int V8 = 32768;
constexpr int SM_ = 34816;
constexpr int SCV = 35072;
constexpr int RED = 36864;
constexpr int N0 = 53248;
DI void sample_item(const Params& P, LAS unsigned char* lds, int item, int wv) {
    int tid_ = (wv << 6) | lane_id(); asm volatile("" : "+v"(tid_)); const int tid = tid_, lane = tid & 63, wave = __builtin_amdgcn_readfirstlane(tid >> 6);
    const int es = item & 7, h = (item >> 3) & 3, b = item >> 5;
    unsigned char* ws = P.ws; float* out = P.out;
    const bf16* P1 = (const bf16*)(ws + WS_P1); const float* GATES = (const float*)(ws + WS_GATES);
    bf16* A3 = (bf16*)(ws + WS_A3); float* HSS = (float*)(ws + WS_HSS);
    const size_t row0 = (size_t)TP + b * 8;
    const bf16* P1S = P1 + P1_S + (size_t)(b * 8) * NP1;
    const float* C0 = P.in[2] + (size_t)(b * NH + h) * DH * DH; const float* n0 = P.in[3] + (size_t)(b * NH + h) * DH; const float m0 = P.in[4][b * NH + h];
    LAS float* qT = (LAS float*)(lds + QT); LAS float* kT = (LAS float*)(lds + KT); LAS float* v8 = (LAS float*)(lds + V8);
    LAS float* Sm = (LAS float*)(lds + SM_); LAS float* scv = (LAS float*)(lds + SCV); LAS float* red = (LAS float*)(lds + RED); LAS float* nn = (LAS float*)(lds + N0);
    const int dg = tid >> 4, e4 = tid & 15;
    f32x4 cin[16];
#pragma unroll
    for (int dd = 0; dd < 16; ++dd) cin[dd] = *(const f32x4*)(C0 + (size_t)(dg * 16 + dd) * DH + es * 64 + 4 * e4);
    __syncthreads();
    float bcum[8], mt[8], ig[8]; float run = 0.f;
#pragma unroll
    for (int t = 0; t < 8; ++t) { const float* gp = GATES + (row0 + t) * 8; ig[t] = gp[h]; run += gp[4 + h]; bcum[t] = run; }
#pragma unroll
    for (int t = 0; t < 8; ++t) { float mx = bcum[t] + m0;
#pragma unroll
        for (int s = 0; s < 8; ++s) if (s <= t) mx = fmaxf(mx, bcum[t] - bcum[s] + ig[s]);
        mt[t] = mx; }
    const float mnew = mt[7]; const float decay = __expf(bcum[7] + m0 - mnew);
    float wsv[8];
#pragma unroll
    for (int s = 0; s < 8; ++s) wsv[s] = __expf(bcum[7] - bcum[s] + ig[s] - mnew);
    { const int d = tid;
#pragma unroll
        for (int t = 0; t < 8; ++t) { const float qv = bf_lo((unsigned)P1S[(size_t)t * NP1 + h * 512 + d]); const float kv = bf_lo((unsigned)P1S[(size_t)t * NP1 + 2048 + h * 512 + d]);
            qT[d * 8 + t] = qv; kT[d * 8 + t] = kv; }
        nn[d] = n0[d];
        const int t = tid >> 6, e = tid & 63; v8[t * 64 + e] = bf_lo((unsigned)P1S[(size_t)t * NP1 + 4096 + h * 512 + es * 64 + e]); }
    __syncthreads();
    { const int t = wave; float acc[9];
#pragma unroll
        for (int s = 0; s < 9; ++s) acc[s] = 0.f;
#pragma unroll
        for (int i = 0; i < 8; ++i) { const int d = lane + 64 * i; const float qv = qT[d * 8 + t];
#pragma unroll
            for (int s = 0; s < 8; ++s) acc[s] += qv * kT[d * 8 + s];
            acc[8] += qv * nn[d]; }
#pragma unroll
        for (int s = 0; s < 9; ++s) acc[s] = wave_sum(acc[s]);
        if (lane < 8) { float val = 0.f;
#pragma unroll
            for (int s = 0; s < 8; ++s) val = (lane == s) ? acc[s] : val;
            const int s = lane; float bt = 0.f, bs = 0.f, igs = 0.f, mtt = 0.f;
#pragma unroll
            for (int u = 0; u < 8; ++u) { bt = (u == t) ? bcum[u] : bt; mtt = (u == t) ? mt[u] : mtt; bs = (u == s) ? bcum[u] : bs; igs = (u == s) ? ig[u] : igs; }
            Sm[t * 8 + s] = (s <= t) ? val * __expf(bt - bs + igs - mtt) : 0.f;
            if (lane == 0) { scv[t] = __expf(bt + m0 - mtt); scv[8 + t] = __expf(-mtt); scv[16 + t] = acc[8]; } }
    }
    __syncthreads();
    { const int d = tid;
#pragma unroll
        for (int s = 0; s < 8; ++s) kT[d * 8 + s] *= wsv[s]; }
    __syncthreads();
    f32x4 acc[8];
#pragma unroll
    for (int t = 0; t < 8; ++t) acc[t] = (f32x4){0.f, 0.f, 0.f, 0.f};
    f32x4 vv[8];
#pragma unroll
    for (int s = 0; s < 8; ++s) vv[s] = *(const LAS f32x4*)(v8 + s * 64 + 4 * e4);
    float* Cout = out + O_CS + (size_t)(b * NH + h) * DH * DH;
#pragma unroll
    for (int dd = 0; dd < 16; ++dd) { const int d = dg * 16 + dd;
        const f32x4 c = cin[dd];
        const f32x4 q0 = *(const LAS f32x4*)(qT + d * 8), q1 = *(const LAS f32x4*)(qT + d * 8 + 4);
        const f32x4 k0 = *(const LAS f32x4*)(kT + d * 8), k1 = *(const LAS f32x4*)(kT + d * 8 + 4);
        acc[0] += c * q0[0]; acc[1] += c * q0[1]; acc[2] += c * q0[2]; acc[3] += c * q0[3]; acc[4] += c * q1[0]; acc[5] += c * q1[1]; acc[6] += c * q1[2]; acc[7] += c * q1[3];
        f32x4 cn = c * decay;
        cn += vv[0] * k0[0]; cn += vv[1] * k0[1]; cn += vv[2] * k0[2]; cn += vv[3] * k0[3]; cn += vv[4] * k1[0]; cn += vv[5] * k1[1]; cn += vv[6] * k1[2]; cn += vv[7] * k1[3];
        *(f32x4*)(Cout + (size_t)d * DH + es * 64 + 4 * e4) = cn; }
#pragma unroll
    for (int t = 0; t < 8; ++t)
#pragma unroll
        for (int j = 0; j < 4; ++j) { acc[t][j] = xsum32(xsum16(acc[t][j])); }
    if (lane < 16) {
#pragma unroll
        for (int t = 0; t < 8; ++t) *(LAS f32x4*)(red + (wave * 8 + t) * 64 + 4 * e4) = acc[t]; }
    __syncthreads();
    { const int t = tid >> 6, e = tid & 63;
        float yin = 0.f;
#pragma unroll
        for (int w = 0; w < 8; ++w) yin += red[(w * 8 + t) * 64 + e];
        float num = 0.f, den = 0.f;
#pragma unroll
        for (int s = 0; s < 8; ++s) { const float sv = Sm[t * 8 + s]; num += sv * v8[s * 64 + e]; den += sv; }
        const float inter = scv[t]; num += inter * yin; den += inter * scv[16 + t];
        const float hv = num / fmaxf(fabsf(den), scv[8 + t]);
        const size_t row = row0 + t;
        const float ov = bf_lo((unsigned)P1S[(size_t)t * NP1 + 6144 + h * 512 + es * 64 + e]), zv = bf_lo((unsigned)P1S[(size_t)t * NP1 + 8192 + h * 512 + es * 64 + e]);
        A3[row * DI_ + h * 512 + es * 64 + e] = (bf16)f2bf(hv * fgate(ov, zv));
        const float ssq = wave_sum(hv * hv);
        if (lane == 0) HSS[row * 32 + h * 8 + es] = ssq;
    }
    if (es == 0) { const int d = tid; float a = nn[d] * decay;
#pragma unroll
        for (int s = 0; s < 8; ++s) a += kT[d * 8 + s];
        out[O_NS + (size_t)(b * NH + h) * DH + d] = a; if (tid == 0) out[O_MS + b * NH + h] = mnew; }
}
}

DI int t5_bucket(int dist) {
    if (dist < 16) return dist;
    const float d = (float)dist;
    const int large = 16 + (int)(logf(d / 16.0f) / 4.852030263919617f * 16.0f);
    return large < 31 ? large : 31;
}
namespace attn {
constexpr int KS = 0, VS = 32768, BIAS = 65536;
constexpr int NITEMS = BATCH * NQH * 32;
struct ItemGeo { int head, b, dil, rcl, nb; size_t rowb; };
DI ItemGeo item_geo(int item) {
    ItemGeo g; const int cb = item & 31; g.head = (item >> 5) % NQH; g.b = item / (32 * NQH);
    const int grp = g.head >> 3; g.dil = grp == 0 ? 1 : (grp == 1 ? 4 : 16); const int nbk = 32 / g.dil;
    g.rcl = cb / nbk; g.nb = cb % nbk; g.rowb = (size_t)g.b * SEQ; return g;
}
struct ItemRegs { v4u k[2], v[2]; bf16x8 q[2]; float bias; };
constexpr int KBLK = 32768;
constexpr int ABIAS = 3 * KBLK;
DI void blk_load(v4u (&k)[2], v4u (&v)[2], const Params& P, const ItemGeo& g, int blk, int tid) {
    const bf16* KVQZ = (const bf16*)(P.ws + WS_KVQZ);
#pragma unroll
    for (int i = 0; i < 2; ++i) { const int L = i * NTHR + tid, kj = L >> 3, ch = L & 7; const size_t row = g.rowb + (size_t)(blk * 128 + kj) * g.dil + g.rcl;
        k[i] = *(const v4u*)(KVQZ + row * N2 + g.head * 64 + ch * 8); v[i] = *(const v4u*)(KVQZ + row * N2 + QW + g.head * 64 + ch * 8); }
}
DI void blk_store(const v4u (&k)[2], const v4u (&v)[2], LAS unsigned char* slot, int tid) {
#pragma unroll
    for (int i = 0; i < 2; ++i) { const int L = i * NTHR + tid, kj = L >> 3, ch = L & 7;
        *(LAS v4u*)(slot + kj * 128 + ((ch ^ (kj & 7)) << 4)) = k[i]; *(LAS v4u*)(slot + 16384 + kj * 128 + ((ch ^ (2 * ((kj >> 1) & 3))) << 4)) = v[i]; }
}
DI void item_load(ItemRegs& R, const Params& P, const ItemGeo& g, int tid, int wave, int x15, int G4) {
    const bf16* KVQZ = (const bf16*)(P.ws + WS_KVQZ);
    blk_load(R.k, R.v, P, g, g.nb, tid);
    const int qi = 16 * wave + x15; const size_t qrow = g.rowb + (size_t)(g.nb * 128 + qi) * g.dil + g.rcl;
#pragma unroll
    for (int ks = 0; ks < 2; ++ks) R.q[ks] = *(const bf16x8*)(KVQZ + qrow * N2 + 2 * QW + g.head * 64 + 32 * ks + 8 * G4);
    { const int rel = 159 - tid; R.bias = (tid < 192 && rel >= 0 && rel <= 128) ? P.in[19][t5_bucket(rel * g.dil) * NQH + g.head] : -INFINITY; }
}
DI void prompt_phase(const Params& P, LAS unsigned char* lds, int vcu, int G, int wv) {
    int tid_ = (wv << 6) | lane_id(); asm volatile("" : "+v"(tid_)); const int tid = tid_, lane = tid & 63, wave = __builtin_amdgcn_readfirstlane(tid >> 6);
    const int x15 = lane & 15, G4 = lane >> 4;
    unsigned char* ws = P.ws;
    bf16* OG = (bf16*)(ws + WS_OG); float* LSE = (float*)(ws + WS_LSE);
    const int per = (NITEMS + G - 1) / G; int item = vcu * per; const int iend = (item + per < NITEMS) ? item + per : NITEMS;
    if (item >= iend) return;
    __syncthreads();
    ItemRegs R; ItemGeo g = item_geo(item);
    int sl = 1;
    {
        v4u pk[2], pv[2];
        if (g.nb > 0) blk_load(pk, pv, P, g, g.nb - 1, tid); else { pk[0] = pk[1] = pv[0] = pv[1] = (v4u){0u, 0u, 0u, 0u}; }
        item_load(R, P, g, tid, wave, x15, G4);
        blk_store(pk, pv, lds + 0 * KBLK, tid);
        blk_store(R.k, R.v, lds + 1 * KBLK, tid);
        if (tid < 192) ((LAS float*)(lds + ABIAS))[tid] = R.bias; }
    bf16x8 qf[2] = {R.q[0], R.q[1]};
    __syncthreads();
    int par = 0;
    for (;;) {
        const int nxt = item + 1; const bool has_next = nxt < iend;
        ItemGeo gn = g;
        if (has_next) { gn = item_geo(nxt); item_load(R, P, gn, tid, wave, x15, G4); }
        const int slp = (sl == 0) ? 2 : sl - 1, sln = (sl == 2) ? 0 : sl + 1;
        const LAS unsigned char* CB = lds + sl * KBLK; const LAS unsigned char* PB = lds + slp * KBLK;
        const int nb = g.nb, dil = g.dil, head = g.head;
        const int qi = 16 * wave + x15; const size_t qrow = g.rowb + (size_t)(nb * 128 + qi) * dil + g.rcl;
        const int base = wave & ~1;
        f32x4 S[10];
        { bf16x8 Af[10][2];
#pragma unroll
          for (int kt = 0; kt < 10; ++kt) { const int T = base + kt; const LAS unsigned char* kb = (T < 8) ? PB : CB; const int key = 16 * (T & 7) + x15;
#pragma unroll
              for (int ks = 0; ks < 2; ++ks) Af[kt][ks] = *(const LAS bf16x8*)(kb + key * 128 + (((4 * ks + G4) ^ (key & 7)) << 4)); }
          SC2_W();
#pragma unroll
          for (int kt = 0; kt < 10; ++kt) { S[kt] = (f32x4){0.f, 0.f, 0.f, 0.f};
#pragma unroll
              for (int ks = 0; ks < 2; ++ks) S[kt] = MFMA16(Af[kt][ks], qf[ks], S[kt]); }
          SC2_SB(); }
        const int i16 = lane & 15, q4 = i16 >> 2, p4 = i16 & 3;
        float bl[10][4]; s16x4 vlo[5][4], vhi[5][4];
        { const LAS float* BL = (const LAS float*)(lds + ABIAS + par * 768) + (4 * G4 - x15 - 16 * (wave - base) + 31);
#pragma unroll
          for (int kt = 0; kt < 10; ++kt)
#pragma unroll
              for (int r = 0; r < 4; ++r) bl[kt][r] = BL[16 * kt + r];
#pragma unroll
          for (int kp = 0; kp < 5; ++kp) {
              const int T0 = base + 2 * kp;
              const int keyr = 16 * (T0 & 7) + 4 * G4 + q4; const int mm = (keyr >> 1) & 3;
              const unsigned vb = (unsigned)(uintptr_t)((T0 < 8) ? PB : CB) + 16384u + (unsigned)(keyr * 128 + 8 * p4);
              const unsigned v0 = vb + (unsigned)((0 ^ mm) << 5), v1 = vb + (unsigned)((1 ^ mm) << 5), v2 = vb + (unsigned)((2 ^ mm) << 5), v3 = vb + (unsigned)((3 ^ mm) << 5);
              asm volatile("ds_read_b64_tr_b16 %0, %8\n\tds_read_b64_tr_b16 %1, %9\n\tds_read_b64_tr_b16 %2, %10\n\tds_read_b64_tr_b16 %3, %11\n\t"
                           "ds_read_b64_tr_b16 %4, %8 offset:2048\n\tds_read_b64_tr_b16 %5, %9 offset:2048\n\tds_read_b64_tr_b16 %6, %10 offset:2048\n\tds_read_b64_tr_b16 %7, %11 offset:2048"
                           : "=&v"(vlo[kp][0]), "=&v"(vlo[kp][1]), "=&v"(vlo[kp][2]), "=&v"(vlo[kp][3]), "=&v"(vhi[kp][0]), "=&v"(vhi[kp][1]), "=&v"(vhi[kp][2]), "=&v"(vhi[kp][3]) : "v"(v0), "v"(v1), "v"(v2), "v"(v3) : "memory"); }
          SC2_W(); }
        float mx = -INFINITY;
#pragma unroll
        for (int kt = 0; kt < 10; ++kt) { const bool dead = (nb == 0) && (base + kt < 8);
#pragma unroll
            for (int r = 0; r < 4; ++r) { const float sl_ = S[kt][r] * 0.125f + bl[kt][r]; const float sv = dead ? -INFINITY : sl_; S[kt][r] = sv; mx = fmaxf(mx, sv); } }
        mx = xmax32(xmax16(mx));
        float sum = 0.f;
#pragma unroll
        for (int kt = 0; kt < 10; ++kt)
#pragma unroll
            for (int r = 0; r < 4; ++r) { const float pe = __builtin_amdgcn_exp2f((S[kt][r] - mx) * 1.4426950408889634f); S[kt][r] = pe; sum += pe; }
        sum = xsum32(xsum16(sum));
        const float rinv = __builtin_amdgcn_rcpf(sum);
        f32x4 O[4];
#pragma unroll
        for (int dt = 0; dt < 4; ++dt) O[dt] = (f32x4){0.f, 0.f, 0.f, 0.f};
#pragma unroll
        for (int kp = 0; kp < 5; ++kp) {
            v4u pb; pb.x = pk2(S[2 * kp][0], S[2 * kp][1]); pb.y = pk2(S[2 * kp][2], S[2 * kp][3]); pb.z = pk2(S[2 * kp + 1][0], S[2 * kp + 1][1]); pb.w = pk2(S[2 * kp + 1][2], S[2 * kp + 1][3]);
            const bf16x8 Bp = __builtin_bit_cast(bf16x8, pb);
#pragma unroll
            for (int dt = 0; dt < 4; ++dt) O[dt] = MFMA16(scan::cat8(vlo[kp][dt], vhi[kp][dt]), Bp, O[dt]);
        }
        bf16* op = OG + qrow * QW + head * 64;
#pragma unroll
        for (int dt = 0; dt < 4; ++dt) { v2u w; w.x = pk2(O[dt][0] * rinv, O[dt][1] * rinv); w.y = pk2(O[dt][2] * rinv, O[dt][3] * rinv); *(v2u*)(op + 16 * dt + 4 * G4) = w; }
        if (G4 == 0) LSE[qrow * NQH + head] = mx + __logf(sum);
        if (!has_next) break;
        blk_store(R.k, R.v, lds + sln * KBLK, tid);
        if (tid < 192) ((LAS float*)(lds + ABIAS + (par ^ 1) * 768))[tid] = R.bias;
        qf[0] = R.q[0]; qf[1] = R.q[1];
        item = nxt; g = gn; par ^= 1; sl = sln;
        __syncthreads();
    }
    __syncthreads();
}

DI void sample_item(const Params& P, int item, int lane) {
    const int head = item % NQH, s = (item / NQH) & 7, b = item / (NQH * 8);
    const int grp = head >> 3, hs = head & 7; const int dil = grp == 0 ? 1 : (grp == 1 ? 4 : 16); const int L = grp == 0 ? 128 : (grp == 1 ? 512 : 2048);
    const float* buf = P.in[5 + grp] + (size_t)b * L * 1024;
    unsigned char* ws = P.ws;
    const bf16* KVQZ = (const bf16*)(ws + WS_KVQZ); bf16* OG = (bf16*)(ws + WS_OG); float* LSE = (float*)(ws + WS_LSE);
    const size_t row = (size_t)TP + b * 8 + s;
    const int kq = lane >> 4, dl = lane & 15;
    f32x4 q; { const v2u qv = *(const v2u*)(KVQZ + row * N2 + 2 * QW + head * 64 + 4 * dl); q = (f32x4){bf_lo(qv.x), bf_hi(qv.x), bf_lo(qv.y), bf_hi(qv.y)}; }
    float m = -INFINITY, l = 0.f; f32x4 acc = (f32x4){0.f, 0.f, 0.f, 0.f};
    for (int j0 = 0; j0 < 132; j0 += 16) {
        f32x4 kv[4], vv[4]; bool ok[4]; float bia[4];
#pragma unroll
        for (int u = 0; u < 4; ++u) { const int j = j0 + 4 * u + kq; ok[u] = j <= 128; kv[u] = (f32x4){0.f, 0.f, 0.f, 0.f}; vv[u] = kv[u]; bia[u] = 0.f;
            if (ok[u]) { const int idx = L + s - dil * j; bia[u] = P.in[19][t5_bucket(dil * j) * NQH + head];
                if (idx >= L) { const size_t r2 = (size_t)TP + b * 8 + (idx - L);
                    const v2u ku = *(const v2u*)(KVQZ + r2 * N2 + head * 64 + 4 * dl), vu = *(const v2u*)(KVQZ + r2 * N2 + QW + head * 64 + 4 * dl);
                    kv[u] = (f32x4){bf_lo(ku.x), bf_hi(ku.x), bf_lo(ku.y), bf_hi(ku.y)}; vv[u] = (f32x4){bf_lo(vu.x), bf_hi(vu.x), bf_lo(vu.y), bf_hi(vu.y)}; }
                else { const float* rp = buf + (size_t)idx * 1024 + hs * 64 + 4 * dl; kv[u] = *(const f32x4*)rp; vv[u] = *(const f32x4*)(rp + 512); } } }
#pragma unroll
        for (int u = 0; u < 4; ++u) {
            float d = (q[0] * kv[u][0] + q[1] * kv[u][1]) + (q[2] * kv[u][2] + q[3] * kv[u][3]);
            d += __shfl_xor(d, 1); d += __shfl_xor(d, 2); d += __shfl_xor(d, 4); d += __shfl_xor(d, 8);
            if (ok[u]) { const float sc = d * 0.125f + bia[u];
                const float mn = fmaxf(m, sc); const float al = __expf(m - mn), p = __expf(sc - mn);
                l = l * al + p; acc = acc * al + vv[u] * p; m = mn; } }
    }
#pragma unroll
    for (int o = 16; o < 64; o <<= 1) { const float m2 = __shfl_xor(m, o), l2 = __shfl_xor(l, o); f32x4 a2; a2[0] = __shfl_xor(acc[0], o); a2[1] = __shfl_xor(acc[1], o); a2[2] = __shfl_xor(acc[2], o); a2[3] = __shfl_xor(acc[3], o);
        const float mn = fmaxf(m, m2); const float f1 = __expf(m - mn), f2 = __expf(m2 - mn); l = l * f1 + l2 * f2; acc = acc * f1 + a2 * f2; m = mn; }
    if (kq == 0) { const float ri = 1.0f / l; v2u w; w.x = pk2(acc[0] * ri, acc[1] * ri); w.y = pk2(acc[2] * ri, acc[3] * ri); *(v2u*)(OG + row * QW + head * 64 + 4 * dl) = w;
        if (dl == 0) LSE[row * NQH + head] = m + __logf(l); }
}
}

DI void merge_phase(const Params& P, int vcu, int G, int wv) {
    int tid_ = (wv << 6) | lane_id(); asm volatile("" : "+v"(tid_));
    unsigned char* ws = P.ws;
    const bf16* KVQZ = (const bf16*)(ws + WS_KVQZ); const bf16* OG = (const bf16*)(ws + WS_OG); const float* LSE = (const float*)(ws + WS_LSE); bf16* A5 = (bf16*)(ws + WS_A5);
    const size_t total = (size_t)M * 64;
    for (size_t i = (size_t)vcu * NTHR + tid_; i < total; i += (size_t)G * NTHR) {
        const size_t row = i >> 6; const int hs = (int)(i & 63) >> 3, d8 = (int)(i & 7) * 8;
        const float l0 = LSE[row * NQH + hs], l1 = LSE[row * NQH + 8 + hs], l2 = LSE[row * NQH + 16 + hs];
        const float mx = fmaxf(l0, fmaxf(l1, l2)); float w0 = __expf(l0 - mx), w1 = __expf(l1 - mx), w2 = __expf(l2 - mx); const float ri = 1.0f / (w0 + w1 + w2); w0 *= ri; w1 *= ri; w2 *= ri;
        const v4u a = *(const v4u*)(OG + row * QW + hs * 64 + d8), bq = *(const v4u*)(OG + row * QW + 512 + hs * 64 + d8), cq = *(const v4u*)(OG + row * QW + 1024 + hs * 64 + d8);
        const v4u z = *(const v4u*)(KVQZ + row * N2 + 3 * QW + hs * 64 + d8);
        v4u o;
#define MRG(f) { const float zl = bf_lo(z.f), zh = bf_hi(z.f); \
        const float vl = (w0 * bf_lo(a.f) + w1 * bf_lo(bq.f) + w2 * bf_lo(cq.f)) * zl * fsigmoid(zl); \
        const float vh = (w0 * bf_hi(a.f) + w1 * bf_hi(bq.f) + w2 * bf_hi(cq.f)) * zh * fsigmoid(zh); o.f = pk2(vl, vh); }
        MRG(x) MRG(y) MRG(z) MRG(w)
#undef MRG
        *(v4u*)(A5 + row * AOUT + hs * 64 + d8) = o;
    }
}

#ifndef REP_P0
#define REP_P0 1
#endif
#ifndef REP_G1
#define REP_G1 1
#endif
#ifndef REP_SCAN
#define REP_SCAN 1
#endif
#ifndef REP_SSCAN
#define REP_SSCAN 1
#endif
#ifndef REP_G3
#define REP_G3 1
#endif
#ifndef REP_G4
#define REP_G4 1
#endif
#ifndef REP_ATT
#define REP_ATT 1
#endif
#ifndef REP_SATT
#define REP_SATT 1
#endif
#ifndef REP_MERGE
#define REP_MERGE 1
#endif

constexpr int SG_LD = 68, SG_PW = 64 * SG_LD;
template <class F> DI void sgemm_tile(LAS unsigned char* lds, const bf16* A, int K, const bf16* Wt, int mt, int nt, int wv, const F& f) {
    const int lane = lane_id(), tid = (wv << 6) | lane, r = lane & 15, g = lane >> 4;
    const int kw = K >> 3, k0w = wv * kw;
    f32x4 acc[4][4];
#pragma unroll
    for (int m = 0; m < 4; ++m)
#pragma unroll
        for (int n = 0; n < 4; ++n) acc[m][n] = (f32x4){0.f, 0.f, 0.f, 0.f};
    const bf16* ap = A + (size_t)(64 * mt + r) * K + k0w + 8 * g; const bf16* bp = Wt + (size_t)(64 * nt + r) * K + k0w + 8 * g;
    for (int ks = 0; ks < (kw >> 5); ++ks) {
        bf16x8 a[4], b[4];
#pragma unroll
        for (int m = 0; m < 4; ++m) { a[m] = *(const bf16x8*)(ap + (size_t)(16 * m) * K + 32 * ks); b[m] = *(const bf16x8*)(bp + (size_t)(16 * m) * K + 32 * ks); }
#pragma unroll
        for (int m = 0; m < 4; ++m)
#pragma unroll
            for (int n = 0; n < 4; ++n) acc[m][n] = MFMA16(a[m], b[n], acc[m][n]);
    }
    __syncthreads();
    LAS float* Pw = (LAS float*)lds + wv * SG_PW;
#pragma unroll
    for (int m = 0; m < 4; ++m)
#pragma unroll
        for (int n = 0; n < 4; ++n)
#pragma unroll
            for (int i = 0; i < 4; ++i) Pw[(16 * m + 4 * g + i) * SG_LD + 16 * n + r] = acc[m][n][i];
    __syncthreads();
    f(tid >> 3, 8 * (tid & 7), (const LAS float*)lds);
    __syncthreads();
}
__global__ void __launch_bounds__(NTHR, 2) yoco_fwd(Params P) {
    extern __shared__ __attribute__((aligned(16))) unsigned char lds_raw[];
    LAS unsigned char* lds = (LAS unsigned char*)lds_raw;
    cg::grid_group grid = cg::this_grid();
    const int G = gridDim.x, bx = blockIdx.x;
    const int wv = __builtin_amdgcn_readfirstlane(threadIdx.x >> 6);
    unsigned char* ws = P.ws;
    int vcu, vrr;
    {
        LAS int* sh = (LAS int*)(lds + LDS_BYTES - 16);
        if (threadIdx.x == 0) {
            unsigned* cnt = (unsigned*)(ws + WS_CTL);
            const unsigned xcc = (unsigned)__builtin_amdgcn_s_getreg((3 << 11) | 20) & 7u;
            const unsigned t = __hip_atomic_fetch_add(cnt + 64 * xcc, 1u, __ATOMIC_RELAXED, __HIP_MEMORY_SCOPE_AGENT);
            unsigned c[8]; unsigned sum = 0; unsigned spins = 0;
            for (;;) { sum = 0;
#pragma unroll
                for (int j = 0; j < 8; ++j) { c[j] = __hip_atomic_load(cnt + 64 * j, __ATOMIC_RELAXED, __HIP_MEMORY_SCOPE_AGENT); sum += c[j]; }
                if (sum == (unsigned)G || ++spins > (1u << 20)) break;
                __builtin_amdgcn_s_sleep(1); }
            bool bal = (sum == (unsigned)G) && (G % 8 == 0);
#pragma unroll
            for (int j = 0; j < 8; ++j) bal = bal && (c[j] == (unsigned)(G / 8));
            if (bal) { sh[0] = (int)(xcc * (unsigned)(G / 8) + t); sh[1] = (int)(t * 8 + xcc); }
            else { sh[0] = (G % 8 == 0) ? (bx % 8) * (G / 8) + bx / 8 : bx; sh[1] = bx; }
        }
        __syncthreads();
        vcu = __builtin_amdgcn_readfirstlane(sh[0]); vrr = __builtin_amdgcn_readfirstlane(sh[1]);
        __syncthreads();
    }
    volatile LAS unsigned* bst = (volatile LAS unsigned*)(lds + LDS_BYTES - 32);
    if (threadIdx.x < 2) bst[threadIdx.x] = 0u;
    __syncthreads();
    XcdBarrier xbar = xcd_barrier_post((unsigned*)(ws + WS_CTL + 16384), bst);
#define GSYNC() xcd_barrier(xbar)

#ifndef NO_P0
    for (int rep_ = 0; rep_ < REP_P0; ++rep_) { p0_phase(P, lds, vcu, G, wv); }
#endif
    if (gridDim.x == 0x7fffffffu) grid.sync();
    GSYNC();
    { pg8::Gemm g{(const bf16*)(ws + WS_XN), (const bf16*)(ws + WS_WA), M, NP1, D}; pg8::StaticOrder S; S.init(M, NP1, G, vrr);
      pg8::EpiP1 E{(bf16*)(ws + WS_P1), NP1};
#ifndef NO_G1
      for (int rep_ = 0; rep_ < REP_G1; ++rep_) { pg8::gemm_phase<pg8::EpiP1, true, true>(lds, g, S, E, wv); }
#endif
 }
    GSYNC();
#ifndef NO_SCAN
    for (int rep_ = 0; rep_ < REP_SCAN; ++rep_) { for (int it = vrr; it < BATCH * NH * 8; it += G) scan2::prompt_scan<0>(P, lds, it, wv); }
#ifdef PROBE_MODE
    for (int it = vrr; it < BATCH * NH * 8; it += G) scan2::prompt_scan<PROBE_MODE>(P, lds, it, wv);
#endif
#endif
#ifndef NO_SSCAN
    for (int rep_ = 0; rep_ < REP_SSCAN; ++rep_) { for (int it = vcu; it < DECB * NH * 8; it += G) sscan::sample_item(P, lds, it, wv); }
#endif
    GSYNC();
    for (int it = vcu; it < 64; it += G) { const int mt = it >> 4, nt = it & 15;
        const float* hss = (const float*)(ws + WS_HSS); const float* xs = P.in[1]; float* outp = P.out + O_Y; bf16* xb = (bf16*)(ws + WS_XN); float* ss1 = (float*)(ws + WS_SS1);
        auto f3 = [&](int row, int c8, const LAS float* Pp) { const int srow = 64 * mt + row; const size_t grow = (size_t)TP + srow; float fh[4];
#pragma unroll
            for (int h = 0; h < 4; ++h) { const f32x4 a = *(const f32x4*)(hss + grow * 32 + h * 8), b2 = *(const f32x4*)(hss + grow * 32 + h * 8 + 4);
                fh[h] = __builtin_amdgcn_rsqf(((a[0] + a[1]) + (a[2] + a[3]) + (b2[0] + b2[1]) + (b2[2] + b2[3])) * (1.0f / 512.0f) + EPS); }
            f32x4 s0 = (f32x4){0.f, 0.f, 0.f, 0.f}, s1 = s0;
#pragma unroll
            for (int w = 0; w < 8; ++w) { const LAS float* q = Pp + w * SG_PW + row * SG_LD + c8; s0 += *(const LAS f32x4*)q * fh[w >> 1]; s1 += *(const LAS f32x4*)(q + 4) * fh[w >> 1]; }
            const size_t o = (size_t)srow * D + 64 * nt + c8; const f32x4 x0 = *(const f32x4*)(xs + o) + s0, x1 = *(const f32x4*)(xs + o + 4) + s1;
            v4u wq; wq.x = pk2(x0[0], x0[1]); wq.y = pk2(x0[2], x0[3]); wq.z = pk2(x1[0], x1[1]); wq.w = pk2(x1[2], x1[3]); *(v4u*)(xb + grow * D + 64 * nt + c8) = wq;
            float ssq = (x0[0] * x0[0] + x0[1] * x0[1]) + (x0[2] * x0[2] + x0[3] * x0[3]) + (x1[0] * x1[0] + x1[1] * x1[1]) + (x1[2] * x1[2] + x1[3] * x1[3]);
            ssq += __shfl_xor(ssq, 1); ssq += __shfl_xor(ssq, 2); ssq += __shfl_xor(ssq, 4);
            if (c8 == 0) ss1[grow * 16 + nt] = ssq; };
        sgemm_tile(lds, (const bf16*)(ws + WS_A3) + (size_t)TP * DI_, DI_, (const bf16*)(ws + WS_WOA), mt, nt, wv, f3); }
    { pg8::Gemm g{(const bf16*)(ws + WS_A3), (const bf16*)(ws + WS_WOA), TP, D, DI_}; pg8::StaticOrder S; S.init(TP, D, G, vrr);
      pg8::EpiG3 E{(const float*)(ws + WS_HSS), (const bf16*)(ws + WS_XN), (const float*)(ws + WS_RNORM), P.out + O_Y, (bf16*)(ws + WS_XN), (float*)(ws + WS_SS1)};
#ifndef NO_G3
      for (int rep_ = 0; rep_ < REP_G3; ++rep_) { pg8::gemm_phase<pg8::EpiG3, true, true>(lds, g, S, E, wv); }
#endif
 }
    GSYNC();
    { pg8::Gemm g{(const bf16*)(ws + WS_XN), (const bf16*)(ws + WS_W2), M, N2, D}; pg8::StaticOrder S; S.init(M, N2, G, vrr);
      pg8::EpiG4 E{(const float*)(ws + WS_SS1), P.in[15], P.in[18], (bf16*)(ws + WS_KVQZ), P.out};
#ifndef NO_G4
      for (int rep_ = 0; rep_ < REP_G4; ++rep_) { pg8::gemm_phase<pg8::EpiG4, true, true>(lds, g, S, E, wv); }
#endif
 }
    GSYNC();
#ifndef NO_ATT
    for (int rep_ = 0; rep_ < REP_ATT; ++rep_) { attn::prompt_phase(P, lds, vcu, G, wv); }
#endif
    { const int wave = wv;
#ifndef NO_SATT
      for (int rep_ = 0; rep_ < REP_SATT; ++rep_) { for (int it = vcu * 8 + wave; it < TS * NQH; it += G * 8) attn::sample_item(P, it, lane_id()); }
#endif
 }
    GSYNC();
#ifndef NO_MERGE
    for (int rep_ = 0; rep_ < REP_MERGE; ++rep_) { merge_phase(P, vcu, G, wv); }
#endif
    GSYNC();
    for (int it = vcu; it < 64; it += G) { const int mt = it >> 4, nt = it & 15; float* outp = P.out + O_Y;
        auto f5 = [&](int row, int c8, const LAS float* Pp) { const size_t grow = (size_t)TP + 64 * mt + row; f32x4 s0 = (f32x4){0.f, 0.f, 0.f, 0.f}, s1 = s0;
#pragma unroll
            for (int w = 0; w < 8; ++w) { const LAS float* q = Pp + w * SG_PW + row * SG_LD + c8; s0 += *(const LAS f32x4*)q; s1 += *(const LAS f32x4*)(q + 4); }
            const v4u xq = *(const v4u*)((const bf16*)(ws + WS_XN) + grow * D + 64 * nt + c8); float* o = outp + grow * D + 64 * nt + c8;
            *(f32x4*)o = (f32x4){bf_lo(xq.x), bf_hi(xq.x), bf_lo(xq.y), bf_hi(xq.y)} + s0; *(f32x4*)(o + 4) = (f32x4){bf_lo(xq.z), bf_hi(xq.z), bf_lo(xq.w), bf_hi(xq.w)} + s1; };
        sgemm_tile(lds, (const bf16*)(ws + WS_A5) + (size_t)TP * AOUT, AOUT, (const bf16*)(ws + WS_WOB), mt, nt, wv, f5); }
    { pg8::Gemm g{(const bf16*)(ws + WS_A5), (const bf16*)(ws + WS_WOB), TP, D, AOUT}; pg8::StaticOrder S; S.init(TP, D, G, vrr);
      pg8::EpiG5 E{P.out + O_Y, (const bf16*)(ws + WS_XN)};
#ifndef NO_G5
      pg8::gemm_phase<pg8::EpiG5, true, true>(lds, g, S, E, wv);
#endif
 }
}

extern "C" void kernel_launch(void* const* d_in, const int* in_sizes, int n_in, void* d_out, int out_size, void* d_ws, size_t ws_size, hipStream_t stream) {
    static int grid = 0;
    if (grid == 0) {
        if (n_in != 21 || (size_t)out_size != O_END || ws_size < WS_NEED) { fprintf(stderr, "kernel_launch: unexpected sizes n_in %d out %d (want %zu) ws %zu (want %zu)\n", n_in, out_size, (size_t)O_END, ws_size, (size_t)WS_NEED); grid = -1; return; }
        int dev = 0, cus = 0, per_cu = 0;
        (void)hipGetDevice(&dev); (void)hipDeviceGetAttribute(&cus, hipDeviceAttributeMultiprocessorCount, dev);
        if (hipFuncSetAttribute((const void*)yoco_fwd, hipFuncAttributeMaxDynamicSharedMemorySize, LDS_BYTES) != hipSuccess) { fprintf(stderr, "kernel_launch: hipFuncSetAttribute failed\n"); grid = -1; return; }
        if (hipOccupancyMaxActiveBlocksPerMultiprocessor(&per_cu, (const void*)yoco_fwd, NTHR, LDS_BYTES) != hipSuccess || per_cu < 1) { fprintf(stderr, "kernel_launch: occupancy query says %d\n", per_cu); per_cu = 1; }
        (void)hipGetLastError();
        grid = cus * 1;
        fprintf(stderr, "kernel_launch: cus %d per_cu %d grid %d\n", cus, per_cu, grid);
    }
    if (grid < 0) return;
    (void)hipMemsetAsync((char*)d_ws + WS_CTL, 0, 65536, stream);
    Params p{};
    for (int i = 0; i < 21; ++i) p.in[i] = (const float*)d_in[i];
    p.out = (float*)d_out; p.ws = (unsigned char*)d_ws;
    void* args[] = {&p};
    hipError_t e = hipLaunchCooperativeKernel((const void*)yoco_fwd, dim3(grid), dim3(NTHR), args, LDS_BYTES, stream);
    if (e != hipSuccess) fprintf(stderr, "cooperative launch failed: %s (grid %d)\n", hipGetErrorString(e), grid);
}
```

```cpp
#include <hip/hip_runtime.h>
#include <hip/hip_cooperative_groups.h>
#include <cstdio>
#include <cstdint>
namespace cg = cooperative_groups;

#define GAS __attribute__((address_space(1)))
#define LAS __attribute__((address_space(3)))
#define DI __device__ __forceinline__
typedef unsigned short bf16;
typedef short bf16x8 __attribute__((ext_vector_type(8)));
typedef short s16x4 __attribute__((ext_vector_type(4)));
typedef float f32x4 __attribute__((ext_vector_type(4)));
typedef float f32x2 __attribute__((ext_vector_type(2)));
typedef float f32x16 __attribute__((ext_vector_type(16)));
typedef unsigned v4u __attribute__((ext_vector_type(4)));
typedef unsigned v2u __attribute__((ext_vector_type(2)));
#define LDS_WAIT() asm volatile("s_waitcnt lgkmcnt(0)" ::: "memory")
#define VM_WAIT() asm volatile("s_waitcnt vmcnt(0)" ::: "memory")
#define MFMA32(a, b, c) __builtin_amdgcn_mfma_f32_32x32x16_bf16((a), (b), (c), 0, 0, 0)
#define MFMA16(a, b, c) __builtin_amdgcn_mfma_f32_16x16x32_bf16((a), (b), (c), 0, 0, 0)

typedef __bf16 bf16x2_t __attribute__((ext_vector_type(2)));
DI unsigned pk2(float lo, float hi) { return __builtin_bit_cast(unsigned, __builtin_convertvector((f32x2){lo, hi}, bf16x2_t)); }
DI unsigned f2bf(float f) { return pk2(f, 0.f) & 0xffffu; }
DI float bf_lo(unsigned u) { return __builtin_bit_cast(float, u << 16); }
DI float bf_hi(unsigned u) { return __builtin_bit_cast(float, u & 0xffff0000u); }
DI float xsum16(float s) { float a = s, b = s; asm("s_nop 1\n\tv_permlane16_swap_b32 %0, %1" : "+v"(a), "+v"(b)); return a + b; }
DI float xsum32(float s) { float a = s, b = s; asm("s_nop 1\n\tv_permlane32_swap_b32 %0, %1" : "+v"(a), "+v"(b)); return a + b; }
DI float xmax16(float s) { float a = s, b = s; asm("s_nop 1\n\tv_permlane16_swap_b32 %0, %1" : "+v"(a), "+v"(b)); return fmaxf(a, b); }
DI float xmax32(float s) { float a = s, b = s; asm("s_nop 1\n\tv_permlane32_swap_b32 %0, %1" : "+v"(a), "+v"(b)); return fmaxf(a, b); }
DI float wave_sum(float v) {
#pragma unroll
    for (int o = 1; o < 16; o <<= 1) v += __shfl_xor(v, o);
    return xsum32(xsum16(v));
}
DI int lane_id() { int l; asm volatile("v_mbcnt_lo_u32_b32 %0, -1, 0\n\tv_mbcnt_hi_u32_b32 %0, -1, %0" : "=v"(l)); return l; }
DI float fsigmoid(float x) { return __builtin_amdgcn_rcpf(1.0f + __builtin_amdgcn_exp2f(-1.4426950408889634f * x)); }
DI float fgate(float o, float z) { return z * __builtin_amdgcn_rcpf((1.0f + __builtin_amdgcn_exp2f(-1.4426950408889634f * o)) * (1.0f + __builtin_amdgcn_exp2f(-1.4426950408889634f * z))); }

constexpr int D = 1024, BATCH = 8, SEQ = 4096, DECB = 32, DECS = 8;
constexpr int TP = BATCH * SEQ, TS = DECB * DECS, M = TP + TS;
constexpr int NH = 4, DI_ = 2048, DH = 512;
constexpr int NP1 = 5 * DI_;
constexpr int WIN_LD = NP1 + 2 * NH;
constexpr int QW = 1536, N2 = 2 * QW + QW + 512;
constexpr int HD = 64, GH = 8, NQH = 24, AOUT = 512;
constexpr float EPS = 1e-6f;

constexpr size_t O_Y = 0;
constexpr size_t O_CP = (size_t)M * D;
constexpr size_t O_NP = O_CP + (size_t)BATCH * NH * DH * DH;
constexpr size_t O_MP = O_NP + (size_t)BATCH * NH * DH;
constexpr size_t O_CS = O_MP + BATCH * NH;
constexpr size_t O_NS = O_CS + (size_t)DECB * NH * DH * DH;
constexpr size_t O_MS = O_NS + (size_t)DECB * NH * DH;
constexpr size_t O_KV128P = O_MS + DECB * NH;
constexpr size_t O_KV512P = O_KV128P + (size_t)BATCH * 128 * 1024;
constexpr size_t O_KV2048P = O_KV512P + (size_t)BATCH * 512 * 1024;
constexpr size_t O_KV128S = O_KV2048P + (size_t)BATCH * 2048 * 1024;
constexpr size_t O_KV512S = O_KV128S + (size_t)TS * 1024;
constexpr size_t O_KV2048S = O_KV512S + (size_t)TS * 1024;
constexpr size_t O_END = O_KV2048S + (size_t)TS * 1024;

constexpr size_t MiB = 1u << 20;
constexpr size_t WS_CTL = 0;
constexpr size_t WS_WA = 1 * MiB;
constexpr size_t WS_WOA = 21 * MiB;
constexpr size_t WS_W2 = 25 * MiB;
constexpr size_t WS_WOB = 35 * MiB;
constexpr size_t WS_XN = 36 * MiB;
constexpr size_t WS_GATES = 101 * MiB;
constexpr size_t WS_RNORM = 103 * MiB;
constexpr size_t WS_HSS = 966 * MiB;
constexpr size_t WS_SS1 = 124 * MiB;
constexpr size_t WS_A3 = 127 * MiB;
constexpr size_t WS_P1 = 256 * MiB;
constexpr size_t WS_KVQZ = 256 * MiB;
constexpr size_t WS_OG = 579 * MiB;
constexpr size_t WS_LSE = 676 * MiB;
constexpr size_t WS_A5 = 680 * MiB;
constexpr size_t WS_SCALG = 901 * MiB;
constexpr size_t WS_NEED = 984 * MiB;
constexpr size_t WS_KP = 713 * MiB, WS_VP = WS_KP + 96 * MiB;
constexpr size_t WS_QP = 127 * MiB;

constexpr size_t P1_V = (size_t)TP * 4096, P1_PART = (size_t)TP * 2048, P1_S = P1_V + 3 * P1_PART;
constexpr int LDS_BYTES = 163840;
constexpr int NTHR = 512;

struct Params { const float* in[21]; float* out; unsigned char* ws; };


typedef GAS unsigned gu32;
#define XB_TMO      128
#define XB_XCNT(j)  (256  + 64 * (j))
#define XB_XSUB(j)  (1280 + 64 * (j))
#define XB_XGEN(j)  (2304 + 64 * (j))
#define XB_TOP      3328
#define XB_TOPGEN   3392
#define XCD_BAR_WORDS 3456
#define XB_SPIN_CAP (1u << 18)

__device__ __forceinline__ unsigned xb_ld(unsigned* p)              { return __hip_atomic_load(p, __ATOMIC_RELAXED, __HIP_MEMORY_SCOPE_AGENT); }
__device__ __forceinline__ unsigned xb_add(unsigned* p, unsigned v) { return __hip_atomic_fetch_add(p, v, __ATOMIC_RELAXED, __HIP_MEMORY_SCOPE_AGENT); }
__device__ __forceinline__ unsigned xb_xcc_id() { return (unsigned)__builtin_amdgcn_s_getreg((3 << 11) | 20) & 0xFu; }
#define XB_SPIN(cond, bar) do { unsigned _sp = 0; while (cond) { __builtin_amdgcn_s_sleep(3); \
    if ((++_sp & 255u) == 0u) { if (xb_ld(&(bar)[XB_TMO])) break; if (_sp > XB_SPIN_CAP) { atomicAdd(&(bar)[XB_TMO], 1u); break; } } } } while (0)

struct XcdBarrier {
    unsigned* bar; unsigned x;
    int wv;
    volatile LAS unsigned* st;
};

#define XB_T0(b) ((b).wv == 0 && lane_id() == 0)
__device__ __forceinline__ XcdBarrier xcd_barrier_post(unsigned* bar, volatile LAS unsigned* st, int wv) {
    XcdBarrier b; b.bar = bar; b.x = xb_xcc_id(); b.st = st; b.wv = wv;
    if (XB_T0(b)) (void)xb_add(&bar[XB_XCNT(b.x)], 1u);
    return b;
}
__device__ __forceinline__ void xcd_barrier_complete(unsigned* bar, unsigned x, unsigned& nloc, unsigned& nx) {
    const unsigned G = gridDim.x * gridDim.y * gridDim.z;
    unsigned sum, cnt, mine, sp = 0u;
    for (;;) {
        sum = 0u; cnt = 0u; mine = 0u;
#pragma unroll
        for (unsigned j = 0; j < 16; ++j) { const unsigned c = xb_ld(&bar[XB_XCNT(j)]); sum += c; cnt += (c > 0u) ? 1u : 0u; mine = (j == x) ? c : mine; }
        if (sum == G) break;
        __builtin_amdgcn_s_sleep(1);
        if ((++sp & 255u) == 0u) { if (xb_ld(&bar[XB_TMO])) break; if (sp > XB_SPIN_CAP) { atomicAdd(&bar[XB_TMO], 1u); break; } }
    }
    nloc = mine > 0u ? mine : 1u; nx = cnt > 0u ? cnt : 1u;
}

__device__ __forceinline__ void xcd_barrier(const XcdBarrier& b) {
    asm volatile("s_waitcnt vmcnt(0)" ::: "memory");
    __syncthreads();
    if (XB_T0(b)) {
        unsigned* bar = b.bar;
        __builtin_amdgcn_s_waitcnt(0);
        unsigned nloc = b.st[0], nx = b.st[1];
        if (nloc == 0u) { xcd_barrier_complete(bar, b.x, nloc, nx); b.st[0] = nloc; b.st[1] = nx; }
        const unsigned old = xb_add(&bar[XB_XSUB(b.x)], 1u);
        const unsigned gen = old / nloc;
        if (old + 1u == (gen + 1u) * nloc) {
            __builtin_amdgcn_fence(__ATOMIC_RELEASE, "agent");
            asm volatile("s_waitcnt vmcnt(0)" ::: "memory");
            const unsigned og = xb_add(&bar[XB_TOP], 1u);
            if (og + 1u != (gen + 1u) * nx) XB_SPIN(xb_ld(&bar[XB_TOP]) < (gen + 1u) * nx, bar);
            __builtin_amdgcn_fence(__ATOMIC_ACQUIRE, "agent");
            asm volatile("s_waitcnt vmcnt(0)" ::: "memory");
        } else {
            XB_SPIN(xb_ld(&bar[XB_TOP]) < (gen + 1u) * nx, bar);
            __builtin_amdgcn_fence(__ATOMIC_ACQUIRE, "agent");
            asm volatile("s_waitcnt vmcnt(0)" ::: "memory");
        }
    }
    __syncthreads();
}

#define XB2_XSUB(s, j) (4096 + 2048 * (s) + 64 * (j))
#define XB2_TOP(s)     (4096 + 2048 * (s) + 1024)
#define XB2_CNT(s)     (4096 + 2048 * (s) + 1088)
__device__ __forceinline__ void xcd_arrive(const XcdBarrier& b, int s) {
    asm volatile("s_waitcnt vmcnt(0)" ::: "memory");
    __syncthreads();
    if (XB_T0(b)) {
        unsigned* bar = b.bar; __builtin_amdgcn_s_waitcnt(0);
        unsigned nloc = b.st[0];
        if (nloc == 0u) { unsigned nx; xcd_barrier_complete(bar, b.x, nloc, nx); b.st[0] = nloc; b.st[1] = nx; }
        const unsigned old = xb_add(&bar[XB2_XSUB(s, b.x)], 1u);
        if (old + 1u == nloc) { __builtin_amdgcn_fence(__ATOMIC_RELEASE, "agent"); asm volatile("s_waitcnt vmcnt(0)" ::: "memory"); xb_add(&bar[XB2_TOP(s)], 1u); }
    }
}
__device__ __forceinline__ void xcd_wait(const XcdBarrier& b, int s) {
    if (XB_T0(b)) {
        unsigned* bar = b.bar; const unsigned nx = b.st[1];
        XB_SPIN(xb_ld(&bar[XB2_TOP(s)]) < nx, bar);
        __builtin_amdgcn_fence(__ATOMIC_ACQUIRE, "agent"); asm volatile("s_waitcnt vmcnt(0)" ::: "memory");
    }
    __syncthreads();
}
__device__ __forceinline__ void cnt_signal(const XcdBarrier& b, int s) {
    asm volatile("s_waitcnt vmcnt(0)" ::: "memory");
    __syncthreads();
    if (XB_T0(b)) { __builtin_amdgcn_s_waitcnt(0); __builtin_amdgcn_fence(__ATOMIC_RELEASE, "agent"); asm volatile("s_waitcnt vmcnt(0)" ::: "memory"); xb_add(&b.bar[XB2_CNT(s)], 1u); }
}
__device__ __forceinline__ void cnt_wait(const XcdBarrier& b, int s, unsigned target) {
    if (XB_T0(b)) { unsigned* bar = b.bar; XB_SPIN(xb_ld(&bar[XB2_CNT(s)]) < target, bar);
        __builtin_amdgcn_fence(__ATOMIC_ACQUIRE, "agent"); asm volatile("s_waitcnt vmcnt(0)" ::: "memory"); }
    __syncthreads();
}

namespace pg8 {
constexpr int BM = 256, BK = 64, HALF = 128, HTB = HALF * BK * 2, STAGE_BYTES = 8 * HTB, NXCD = 8, WGM = 8;
constexpr int XTAB = STAGE_BYTES;
__host__ __device__ __forceinline__ int lds_byte(int r, int c) { const int st = (r >> 4) * 2 + (c >> 5), rr = r & 15, cc = c & 31, ob = rr * 64 + cc * 2; return st * 1024 + (ob ^ (((ob >> 9) & 1) << 5)); }
__host__ __device__ __forceinline__ void stage_rc(int b, int& R, int& C) { const int st = b / 1024, sb = b % 1024, swz = sb ^ (((sb >> 9) & 1) << 5); R = (st >> 1) * 16 + swz / 64; C = (st & 1) * 32 + (swz % 64) / 2; }
__host__ __device__ __forceinline__ int perm32(int rho) { const int n = rho >> 4, i = rho & 15; return 8 * (i >> 2) + 4 * n + (i & 3); }

struct Unit { int pm, pn; };
struct Gemm { const bf16* A; const bf16* Bt; int M, N, K; };
struct StaticOrder {
    int nM, nN, nwg, G, c;
    __device__ void init(int M_, int N_, int G_, int c_) { nM = M_ / BM; nN = N_ / BM; nwg = nM * nN; G = G_; c = c_; }
    __device__ bool next(int i, Unit& u) const {
        const long L = (long)i * G + c; if (L >= nwg) return false;
        int wgid = (int)L; { const int q = nwg / NXCD, r = nwg % NXCD, xcd = wgid % NXCD, off = wgid / NXCD; wgid = (xcd < r ? xcd * (q + 1) : r * (q + 1) + (xcd - r) * q) + off; }
        const int nig = WGM * nN, gid = wgid / nig, fm = gid * WGM, gsz = (nM - fm) < WGM ? (nM - fm) : WGM;
        u.pm = fm + ((wgid % nig) % gsz); u.pn = (wgid % nig) / gsz; return true;
    }
};
DI unsigned cvt_pk_bf16(float lo, float hi) { return pk2(lo, hi); }

template <class Epi, bool ALIGN_EPI, bool SP2>
DI void gemm_phase(LAS unsigned char* lds, const Gemm g, const StaticOrder& S, const Epi& E, int wv) {
    int tid_ = (wv << 6) | lane_id(); asm volatile("" : "+v"(tid_)); const int tid = tid_, wid = __builtin_amdgcn_readfirstlane(tid >> 6), lane = tid & 63, wr = wid >> 2, wc = wid & 3, fr = lane & 15, fq = lane >> 4;
    const int K = g.K, nt = K / BK;
    unsigned voffA[2], voffB[2];
#pragma unroll
    for (int i = 0; i < 2; ++i) { int R, C; stage_rc(tid * 16 + i * 8192, R, C); const int Rb = Epi::PERM ? ((R & ~31) + perm32(R & 31)) : R;
        voffA[i] = (unsigned)(R * K + C) * 2u; voffB[i] = (unsigned)(Rb * K + C) * 2u; }
    const size_t kstep = (size_t)(BK * 2);
    const size_t hstep = (size_t)HALF * K * 2;
    const size_t tstep = 2 * hstep;
    const unsigned ldsw = (unsigned)wid * 1024u;
    const int aoff = lds_byte(wr * 64 + fr, fq * 8), boff = lds_byte(wc * 32 + fr, fq * 8);
#define PG8_SA(b, h) (((b) * 2 + (h)) * HTB)
#define PG8_SB(b, h) ((4 + (b) * 2 + (h)) * HTB)
#define PG8_STAGE(bufoff, gbase, voff) do { _Pragma("unroll") for (int _i = 0; _i < 2; ++_i) \
        __builtin_amdgcn_global_load_lds((const unsigned*)((const char*)(gbase) + (voff)[_i]), (LAS unsigned*)(lds + (bufoff) + ldsw + _i * 8192), 16, 0, 0); } while (0)
#define PG8_LDA(dst, b, h) do { _Pragma("unroll") for (int m = 0; m < 4; ++m) _Pragma("unroll") for (int k = 0; k < 2; ++k) dst[m][k] = *(const LAS bf16x8*)(lds + PG8_SA(b, h) + aoff + m * 2048 + k * 1024); } while (0)
#define PG8_LDB(dst, b, h) do { _Pragma("unroll") for (int n = 0; n < 2; ++n) _Pragma("unroll") for (int k = 0; k < 2; ++k) dst[n][k] = *(const LAS bf16x8*)(lds + PG8_SB(b, h) + boff + n * 2048 + k * 1024); } while (0)
#define PG8_MMA(ai, bj, At, Bt) do { __builtin_amdgcn_s_setprio(1); _Pragma("unroll") for (int m = 0; m < 4; ++m) _Pragma("unroll") for (int n = 0; n < 2; ++n) _Pragma("unroll") for (int k = 0; k < 2; ++k) \
        acc[ai][bj][m][n] = __builtin_amdgcn_mfma_f32_16x16x32_bf16(Bt[n][k], At[m][k], acc[ai][bj][m][n], 0, 0, 0); __builtin_amdgcn_s_setprio(0); } while (0)
#define PG8_WAIT_V(n) asm volatile("s_waitcnt vmcnt(" #n ")" ::: "memory")
#define PG8_WAIT_L(n) asm volatile("s_waitcnt lgkmcnt(" #n ")" ::: "memory")
#define PG8_BAR __builtin_amdgcn_s_barrier()
#define PG8_SCHED __builtin_amdgcn_sched_barrier(0)
    Unit cur, nxt; int ui = 0;
    if (!S.next(0, cur)) return;
    f32x4 acc[2][2][4][2];
#pragma unroll
    for (int a = 0; a < 2; ++a)
#pragma unroll
        for (int b = 0; b < 2; ++b)
#pragma unroll
            for (int m = 0; m < 4; ++m)
#pragma unroll
                for (int n = 0; n < 2; ++n) acc[a][b][m][n] = (f32x4){0.f, 0.f, 0.f, 0.f};
    bf16x8 At[4][2], B0[2][2], B1[2][2];
    const char* cA = (const char*)g.A + (size_t)cur.pm * tstep; const char* cB = (const char*)g.Bt + (size_t)cur.pn * tstep;
    if constexpr (Epi::HAS_PREP) E.prep(cur, 0, lds, tid);
    if constexpr (SP2) {
        PG8_STAGE(PG8_SB(0, 0), cB, voffB); PG8_STAGE(PG8_SB(0, 1), cB + hstep, voffB); PG8_STAGE(PG8_SA(0, 0), cA, voffA); PG8_STAGE(PG8_SA(0, 1), cA + hstep, voffA);
        if (wr == 1) PG8_BAR;
        PG8_WAIT_V(2); PG8_BAR;
        PG8_STAGE(PG8_SB(1, 0), cB + kstep, voffB); PG8_STAGE(PG8_SA(1, 0), cA + kstep, voffA); PG8_STAGE(PG8_SB(1, 1), cB + hstep + kstep, voffB);
        PG8_WAIT_V(6); PG8_BAR;
    } else {
        PG8_STAGE(PG8_SB(0, 0), cB, voffB); PG8_STAGE(PG8_SA(0, 0), cA, voffA); PG8_STAGE(PG8_SB(0, 1), cB + hstep, voffB); PG8_STAGE(PG8_SA(0, 1), cA + hstep, voffA);
        if (wr == 1) PG8_BAR;
        PG8_WAIT_V(4); PG8_BAR;
        PG8_STAGE(PG8_SB(1, 0), cB + kstep, voffB); PG8_STAGE(PG8_SA(1, 0), cA + kstep, voffA); PG8_STAGE(PG8_SB(1, 1), cB + hstep + kstep, voffB);
        PG8_WAIT_V(6); PG8_BAR;
    }
    for (;;) {
        const bool has_next = S.next(ui + 1, nxt);
        const char* nA = has_next ? (const char*)g.A + (size_t)nxt.pm * tstep : cA; const char* nB = has_next ? (const char*)g.Bt + (size_t)nxt.pn * tstep : cB;
        for (int t = 0; t < nt; t += 2) {
            const bool last = (t == nt - 2);
            const char* a1 = cA + (size_t)(t + 1) * kstep;
            const char* a2 = last ? nA : cA + (size_t)(t + 2) * kstep; const char* b2 = last ? nB : cB + (size_t)(t + 2) * kstep;
            const char* a3 = a2 + kstep; const char* b3 = b2 + kstep;
            if constexpr (Epi::HAS_PREP) { if (last && has_next) E.prep(nxt, ui + 1, lds, tid); }
            if constexpr (SP2) {
            PG8_LDB(B0, 0, 0); PG8_LDB(B1, 0, 1); PG8_SCHED; PG8_LDA(At, 0, 0); PG8_STAGE(PG8_SA(1, 1), a1 + hstep, voffA);
            PG8_WAIT_V(8); PG8_WAIT_L(0); PG8_BAR; PG8_MMA(0, 0, At, B0); PG8_MMA(0, 1, At, B1); PG8_BAR; PG8_SCHED;
            PG8_LDA(At, 0, 1); PG8_STAGE(PG8_SB(0, 0), b2, voffB); PG8_STAGE(PG8_SB(0, 1), b2 + hstep, voffB); PG8_STAGE(PG8_SA(0, 0), a2, voffA);
            PG8_WAIT_V(8); PG8_WAIT_L(0); PG8_BAR; PG8_MMA(1, 0, At, B0); PG8_MMA(1, 1, At, B1); PG8_BAR; PG8_SCHED;
            PG8_LDB(B0, 1, 0); PG8_LDB(B1, 1, 1); PG8_SCHED; PG8_LDA(At, 1, 0); PG8_STAGE(PG8_SA(0, 1), a2 + hstep, voffA);
            PG8_WAIT_V(8); PG8_WAIT_L(0); PG8_BAR; PG8_MMA(0, 0, At, B0); PG8_MMA(0, 1, At, B1); PG8_BAR; PG8_SCHED;
            PG8_LDA(At, 1, 1); PG8_STAGE(PG8_SB(1, 0), b3, voffB); PG8_STAGE(PG8_SB(1, 1), b3 + hstep, voffB); PG8_STAGE(PG8_SA(1, 0), a3, voffA);
            PG8_WAIT_V(8); PG8_WAIT_L(0); PG8_BAR; PG8_MMA(1, 0, At, B0); PG8_MMA(1, 1, At, B1); PG8_BAR; PG8_SCHED;
            } else {
            PG8_LDB(B0, 0, 0); PG8_SCHED; PG8_LDA(At, 0, 0); PG8_STAGE(PG8_SA(1, 1), a1 + hstep, voffA);
            PG8_WAIT_L(8); PG8_BAR; PG8_WAIT_L(0); PG8_MMA(0, 0, At, B0); PG8_BAR; PG8_SCHED;
            PG8_LDB(B1, 0, 1); PG8_STAGE(PG8_SB(0, 0), b2, voffB);
            PG8_BAR; PG8_WAIT_L(0); PG8_MMA(0, 1, At, B1); PG8_BAR;
            PG8_LDA(At, 0, 1); PG8_STAGE(PG8_SA(0, 0), a2, voffA);
            PG8_BAR; PG8_WAIT_L(0); PG8_MMA(1, 0, At, B0); PG8_BAR; PG8_SCHED;
            PG8_STAGE(PG8_SB(0, 1), b2 + hstep, voffB);
            PG8_WAIT_V(6); PG8_BAR; PG8_MMA(1, 1, At, B1); PG8_BAR;
            PG8_LDB(B0, 1, 0); PG8_SCHED; PG8_LDA(At, 1, 0); PG8_STAGE(PG8_SA(0, 1), a2 + hstep, voffA);
            PG8_WAIT_L(8); PG8_BAR; PG8_WAIT_L(0); PG8_MMA(0, 0, At, B0); PG8_BAR; PG8_SCHED;
            PG8_LDB(B1, 1, 1); PG8_STAGE(PG8_SB(1, 0), b3, voffB);
            PG8_BAR; PG8_WAIT_L(0); PG8_MMA(0, 1, At, B1); PG8_BAR;
            PG8_LDA(At, 1, 1); PG8_STAGE(PG8_SA(1, 0), a3, voffA);
            PG8_BAR; PG8_WAIT_L(0); PG8_MMA(1, 0, At, B0); PG8_BAR; PG8_SCHED;
            PG8_STAGE(PG8_SB(1, 1), b3 + hstep, voffB);
            PG8_WAIT_V(6); PG8_BAR; PG8_MMA(1, 1, At, B1); PG8_BAR;
            }
            if constexpr (Epi::RESCALE) { if ((((t + 2) & 7) == 0) && !last) E.rescale(acc, ((t + 2) >> 3) - 1, ui, lds, wr, fr); }
        }
        if constexpr (ALIGN_EPI) { if (wr == 0) PG8_BAR; }
        E(acc, cur, ui, lds, wr, wc, fr, fq);
        if (!has_next) break;
#pragma unroll
        for (int a = 0; a < 2; ++a)
#pragma unroll
            for (int b = 0; b < 2; ++b)
#pragma unroll
                for (int m = 0; m < 4; ++m)
#pragma unroll
                    for (int n = 0; n < 2; ++n) acc[a][b][m][n] = (f32x4){0.f, 0.f, 0.f, 0.f};
        cur = nxt; cA = nA; cB = nB; ++ui;
        if constexpr (ALIGN_EPI) { if (wr == 1) PG8_BAR; }
    }
    PG8_WAIT_V(0);
    if constexpr (!ALIGN_EPI) { if (wr == 0) PG8_BAR; }
    PG8_BAR;
#undef PG8_SA
#undef PG8_SB
#undef PG8_STAGE
#undef PG8_LDA
#undef PG8_LDB
#undef PG8_MMA
#undef PG8_WAIT_V
#undef PG8_WAIT_L
#undef PG8_BAR
#undef PG8_SCHED
}


constexpr int XSCR = XTAB + 8192;
DI void wave_xpose(LAS unsigned char* scr, int fr, int c0, int c1, v4u p0, v4u p1, int lane, v4u& o0, v4u& o1) {
    *(LAS v4u*)(scr + fr * 128 + ((c0 ^ (fr & 7)) << 4)) = p0;
    *(LAS v4u*)(scr + fr * 128 + ((c1 ^ (fr & 7)) << 4)) = p1;
    asm volatile("s_waitcnt lgkmcnt(0)" ::: "memory");
    const int r = lane >> 3, c = lane & 7;
    o0 = *(const LAS v4u*)(scr + r * 128 + ((c ^ (r & 7)) << 4));
    o1 = *(const LAS v4u*)(scr + (r + 8) * 128 + ((c ^ (r & 7)) << 4));
    asm volatile("s_waitcnt lgkmcnt(0)" ::: "memory");
}
struct EpiP1 {
    static constexpr bool PERM = true, HAS_PREP = false, RESCALE = false;
    bf16* O; int ldc; int rbase;
    DI void prep(const Unit&, int, LAS unsigned char*, int) const {}
    DI void rescale(f32x4 (&)[2][2][4][2], int, int, LAS unsigned char*, int, int) const {}
    DI void operator()(const f32x4 (&acc)[2][2][4][2], const Unit& u, int, LAS unsigned char* lds, int wr, int wc, int fr, int fq) const {
        const int lane = fr + 16 * fq, wid = wr * 4 + wc;
        LAS unsigned char* scr = lds + XSCR + wid * 2048;
        const int rr = lane >> 3, cc = lane & 7;
        const int col = u.pn * BM + 64 * wc + 8 * cc;
        const int part = col >> 11, hh = (col >> 9) & 3, d = col & 511;
#pragma unroll
        for (int ai = 0; ai < 2; ++ai)
#pragma unroll
            for (int m = 0; m < 4; ++m) { const f32x4 a0 = acc[ai][0][m][0], a1 = acc[ai][0][m][1], b0 = acc[ai][1][m][0], b1 = acc[ai][1][m][1];
                v4u p0, p1; p0.x = cvt_pk_bf16(a0[0], a0[1]); p0.y = cvt_pk_bf16(a0[2], a0[3]); p0.z = cvt_pk_bf16(a1[0], a1[1]); p0.w = cvt_pk_bf16(a1[2], a1[3]);
                p1.x = cvt_pk_bf16(b0[0], b0[1]); p1.y = cvt_pk_bf16(b0[2], b0[3]); p1.z = cvt_pk_bf16(b1[0], b1[1]); p1.w = cvt_pk_bf16(b1[2], b1[3]);
                v4u o[2]; wave_xpose(scr, fr, fq, 4 + fq, p0, p1, lane, o[0], o[1]);
#pragma unroll
                for (int h = 0; h < 2; ++h) { const int row = rbase + u.pm * BM + ai * HALF + wr * 64 + m * 16 + rr + 8 * h; size_t off;
                    if (row >= TP) off = P1_S + (size_t)(row - TP) * NP1 + col;
                    else { const int b = row >> 12, c = (row >> 6) & 63, t = row & 63;
                        if (part < 2) off = ((((size_t)(4 * c + (d >> 7)) * 32 + (b * 4 + hh)) * 2) + part) * 8192 + t * 128 + (d & 127);
                        else off = P1_V + (size_t)(part - 2) * P1_PART + (((size_t)c * 32 + (b * 4 + hh)) * 8 + (d >> 6)) * 4096 + t * 64 + (d & 63); }
                    __builtin_nontemporal_store(o[h], (v4u*)(O + off)); } }
    }
};

struct EpiG3 {
    static constexpr bool PERM = false, HAS_PREP = true, RESCALE = true;
    const float* hss;
    const bf16* xn; const float* rnorm;
    float* out;
    bf16* xb;
    float* ss1;
    DI void prep(const Unit& u, int ui, LAS unsigned char* lds, int tid) const {
        LAS float* T = (LAS float*)(lds + XTAB + (ui & 1) * 4096);
        if (tid < 256) {
            const float* p = hss + (size_t)(u.pm * BM + tid) * 32; float f[4];
#pragma unroll
            for (int h = 0; h < 4; ++h) { float s = 0.f;
#pragma unroll
                for (int j = 0; j < 2; ++j) { const f32x4 v = *(const f32x4*)(p + h * 8 + j * 4); s += (v[0] + v[1]) + (v[2] + v[3]); }
                f[h] = __builtin_amdgcn_rsqf(s * (1.0f / 512.0f) + EPS); }
            *(LAS f32x4*)(T + tid * 4) = (f32x4){f[0] / f[1], f[1] / f[2], f[2] / f[3], f[3]};
        }
        asm volatile("s_waitcnt vmcnt(0) lgkmcnt(0)" ::: "memory"); __builtin_amdgcn_s_barrier(); asm volatile("" ::: "memory");
    }
    DI void rescale(f32x4 (&acc)[2][2][4][2], int seg, int ui, LAS unsigned char* lds, int wr, int fr) const {
        const LAS float* T = (const LAS float*)(lds + XTAB + (ui & 1) * 4096);
#pragma unroll
        for (int ai = 0; ai < 2; ++ai)
#pragma unroll
            for (int m = 0; m < 4; ++m) { const float r = T[(ai * HALF + wr * 64 + m * 16 + fr) * 4 + seg];
#pragma unroll
                for (int bj = 0; bj < 2; ++bj)
#pragma unroll
                    for (int n = 0; n < 2; ++n) acc[ai][bj][m][n] = acc[ai][bj][m][n] * r; }
    }
    DI void operator()(const f32x4 (&acc)[2][2][4][2], const Unit& u, int ui, LAS unsigned char* lds, int wr, int wc, int fr, int fq) const {
        const LAS float* T = (const LAS float*)(lds + XTAB + (ui & 1) * 4096);
        const int lane = fr + 16 * fq, wid = wr * 4 + wc;
        LAS unsigned char* scr = lds + XSCR + wid * 2048;
        const int rr = lane >> 3, cc = lane & 7;
        v2u xv[2][2][2]; float rn[2][2];
        auto xoff = [&](int ai, int m, int bj, int h) -> size_t { return (size_t)(u.pm * BM + ai * HALF + wr * 64 + m * 16 + rr + 8 * h) * D + u.pn * BM + bj * HALF + wc * 32 + 4 * cc; };
#pragma unroll
        for (int h = 0; h < 2; ++h) { rn[0][h] = rnorm[u.pm * BM + wr * 64 + rr + 8 * h];
#pragma unroll
            for (int bj = 0; bj < 2; ++bj) xv[0][bj][h] = *(const v2u*)(xn + xoff(0, 0, bj, h)); }
#pragma unroll
        for (int gi = 0; gi < 8; ++gi) { const int ai = gi >> 2, m = gi & 3;
            if (gi < 7) {
#pragma unroll
                for (int h = 0; h < 2; ++h) { rn[(gi + 1) & 1][h] = rnorm[u.pm * BM + ((gi + 1) >> 2) * HALF + wr * 64 + ((gi + 1) & 3) * 16 + rr + 8 * h];
#pragma unroll
                    for (int bj = 0; bj < 2; ++bj) xv[(gi + 1) & 1][bj][h] = *(const v2u*)(xn + xoff((gi + 1) >> 2, (gi + 1) & 3, bj, h)); } }
            const float r = T[(ai * HALF + wr * 64 + m * 16 + fr) * 4 + 3];
            float ssq[2] = {0.f, 0.f};
#pragma unroll
            for (int bj = 0; bj < 2; ++bj) { v4u o0, o1;
                wave_xpose(scr, fr, fq, 4 + fq, __builtin_bit_cast(v4u, acc[ai][bj][m][0] * r), __builtin_bit_cast(v4u, acc[ai][bj][m][1] * r), lane, o0, o1);
#pragma unroll
                for (int h = 0; h < 2; ++h) { const int row = u.pm * BM + ai * HALF + wr * 64 + m * 16 + rr + 8 * h; const int c = u.pn * BM + bj * HALF + wc * 32 + 4 * cc;
                    const v2u xq = xv[gi & 1][bj][h]; const float rnh = rn[gi & 1][h];
                    const f32x4 o = (f32x4){bf_lo(xq.x), bf_hi(xq.x), bf_lo(xq.y), bf_hi(xq.y)} * rnh + __builtin_bit_cast(f32x4, h ? o1 : o0);
                    ssq[h] += (o[0] * o[0] + o[1] * o[1]) + (o[2] * o[2] + o[3] * o[3]);
                    v2u w; w.x = cvt_pk_bf16(o[0], o[1]); w.y = cvt_pk_bf16(o[2], o[3]); *(v2u*)(xb + (size_t)row * D + c) = w; } }
#pragma unroll
            for (int h = 0; h < 2; ++h) { float s = ssq[h]; s += __shfl_xor(s, 1); s += __shfl_xor(s, 2); s += __shfl_xor(s, 4);
                if (cc == 0) ss1[(size_t)(u.pm * BM + ai * HALF + wr * 64 + m * 16 + rr + 8 * h) * 16 + u.pn * 4 + wc] = s; }
        }
    }
};

struct EpiG4 {
    static constexpr bool PERM = true, HAS_PREP = true, RESCALE = false;
    const float* ss1;
    const float* kgain; const float* qgain;
    bf16* O;
    unsigned char* wsb;
    float* out;
    int rbase;
    DI void prep(const Unit& u, int ui, LAS unsigned char* lds, int tid) const {
        LAS float* T = (LAS float*)(lds + XTAB + (ui & 1) * 4096);
        if (tid < 256) { const float* p = ss1 + (size_t)(rbase + u.pm * BM + tid) * 16; float s = 0.f;
#pragma unroll
            for (int j = 0; j < 4; ++j) { const f32x4 v = *(const f32x4*)(p + j * 4); s += (v[0] + v[1]) + (v[2] + v[3]); }
            T[tid] = __builtin_amdgcn_rsqf(s * (1.0f / 1024.0f) + EPS); }
        asm volatile("s_waitcnt vmcnt(0) lgkmcnt(0)" ::: "memory"); __builtin_amdgcn_s_barrier(); asm volatile("" ::: "memory");
    }
    DI void rescale(f32x4 (&)[2][2][4][2], int, int, LAS unsigned char*, int, int) const {}
    DI void operator()(const f32x4 (&acc)[2][2][4][2], const Unit& u, int ui, LAS unsigned char* lds, int wr, int wc, int fr, int fq) const {
        const LAS float* T = (const LAS float*)(lds + XTAB + (ui & 1) * 4096);
        const int lane = fr + 16 * fq, wid = wr * 4 + wc, rr = lane >> 3, cc = lane & 7;
        LAS unsigned char* scr = lds + XSCR + wid * 2048;
        const int pn = u.pn; const int kind = pn < 6 ? 0 : (pn < 12 ? 1 : (pn < 18 ? 2 : 3));
        const bool normed = (kind == 0 || kind == 2);
        const float* gp = (kind == 0) ? kgain : qgain;
        f32x4 gv[2][2];
#pragma unroll
        for (int bj = 0; bj < 2; ++bj)
#pragma unroll
            for (int n = 0; n < 2; ++n) gv[bj][n] = normed ? *(const f32x4*)(gp + 32 * bj + 8 * fq + 4 * n) : (f32x4){1.f, 1.f, 1.f, 1.f};
        const int lcol = pn * BM + 64 * wc + 8 * fq;
        const int hq = (kind < 3) ? (pn - 6 * kind) * 4 + wc : 0; const int lgd = hq < 8 ? 0 : (hq < 16 ? 2 : 4);
        const size_t kvoff = (kind == 0) ? WS_KP : ((kind == 1) ? WS_VP : WS_QP); bf16* kvqp = (bf16*)(wsb + kvoff);
        const int head = (kind < 2) ? ((pn - 6 * kind) * 4 + wc) : 0;
        const int grp = head >> 3, hs = head & 7;
        const int wrows = grp == 0 ? 128 : (grp == 1 ? 512 : 2048);
        const size_t obase_p = grp == 0 ? O_KV128P : (grp == 1 ? O_KV512P : O_KV2048P);
        const size_t obase_s = grp == 0 ? O_KV128S : (grp == 1 ? O_KV512S : O_KV2048S);
#pragma unroll
        for (int ai = 0; ai < 2; ++ai)
#pragma unroll
            for (int m = 0; m < 4; ++m) { const int rl = ai * HALF + wr * 64 + m * 16 + fr; const int row = rbase + u.pm * BM + rl; const float rs = T[rl];
                f32x4 x[2][2]; float ssq = 0.f;
#pragma unroll
                for (int bj = 0; bj < 2; ++bj)
#pragma unroll
                    for (int n = 0; n < 2; ++n) { x[bj][n] = acc[ai][bj][m][n] * rs; ssq += (x[bj][n][0] * x[bj][n][0] + x[bj][n][1] * x[bj][n][1]) + (x[bj][n][2] * x[bj][n][2] + x[bj][n][3] * x[bj][n][3]); }
                if (normed) { ssq = xsum32(xsum16(ssq)); const float hr = __builtin_amdgcn_rsqf(ssq * (1.0f / 64.0f) + EPS);
#pragma unroll
                    for (int bj = 0; bj < 2; ++bj)
#pragma unroll
                        for (int n = 0; n < 2; ++n) x[bj][n] = x[bj][n] * hr * gv[bj][n]; }
                {
                  v4u wq[2];
#pragma unroll
                  for (int bj = 0; bj < 2; ++bj) { wq[bj].x = cvt_pk_bf16(x[bj][0][0], x[bj][0][1]); wq[bj].y = cvt_pk_bf16(x[bj][0][2], x[bj][0][3]); wq[bj].z = cvt_pk_bf16(x[bj][1][0], x[bj][1][1]); wq[bj].w = cvt_pk_bf16(x[bj][1][2], x[bj][1][3]); }
                  v4u o2[2]; wave_xpose(scr, fr, fq, 4 + fq, wq[0], wq[1], lane, o2[0], o2[1]);
#pragma unroll
                  for (int h2 = 0; h2 < 2; ++h2) { const int row2 = rbase + u.pm * BM + ai * HALF + wr * 64 + m * 16 + rr + 8 * h2;
                      bf16* rowp = O + (size_t)row2 * N2 + pn * BM + 64 * wc + 8 * cc;
                      if (kind < 3 && row2 < TP) { const int b = row2 >> 12, t = row2 & 4095;
                          rowp = kvqp + ((size_t)((b * NQH + hq) << 12) + (size_t)(((t & ((1 << lgd) - 1)) << (12 - lgd)) | (t >> lgd))) * 64 + 8 * cc; }
                      __builtin_nontemporal_store(o2[h2], (v4u*)rowp); } }
                if (kind < 2) {
                    float* dst = nullptr;
                    if (row >= TP) dst = out + obase_s + (size_t)(row - TP) * 1024 + kind * 512 + hs * 64;
                    else { const int b = row >> 12, t = row & 4095; if (t >= SEQ - wrows) dst = out + obase_p + ((size_t)b * wrows + (t - (SEQ - wrows))) * 1024 + kind * 512 + hs * 64; }
                    if (dst) {
#pragma unroll
                        for (int bj = 0; bj < 2; ++bj)
#pragma unroll
                            for (int n = 0; n < 2; ++n) *(f32x4*)(dst + 32 * bj + 8 * fq + 4 * n) = x[bj][n]; }
                }
                asm volatile("" ::: "memory"); }
    }
};

struct EpiG5 {
    static constexpr bool PERM = false, HAS_PREP = false, RESCALE = false;
    float* out; const bf16* xb;
    DI void prep(const Unit&, int, LAS unsigned char*, int) const {}
    DI void rescale(f32x4 (&)[2][2][4][2], int, int, LAS unsigned char*, int, int) const {}
    DI void operator()(const f32x4 (&acc)[2][2][4][2], const Unit& u, int, LAS unsigned char* lds, int wr, int wc, int fr, int fq) const {
        const int lane = fr + 16 * fq, wid = wr * 4 + wc;
        LAS unsigned char* scr = lds + XSCR + wid * 2048;
        const int rr = lane >> 3, cc = lane & 7;
        v2u xv[2][2][2];
        auto xoff = [&](int ai, int m, int bj, int h) -> size_t { return (size_t)(u.pm * BM + ai * HALF + wr * 64 + m * 16 + rr + 8 * h) * D + u.pn * BM + bj * HALF + wc * 32 + 4 * cc; };
#pragma unroll
        for (int bj = 0; bj < 2; ++bj)
#pragma unroll
            for (int h = 0; h < 2; ++h) xv[0][bj][h] = *(const v2u*)(xb + xoff(0, 0, bj, h));
#pragma unroll
        for (int gi = 0; gi < 8; ++gi) { const int ai = gi >> 2, m = gi & 3;
            if (gi < 7) {
#pragma unroll
                for (int bj = 0; bj < 2; ++bj)
#pragma unroll
                    for (int h = 0; h < 2; ++h) xv[(gi + 1) & 1][bj][h] = *(const v2u*)(xb + xoff((gi + 1) >> 2, (gi + 1) & 3, bj, h)); }
#pragma unroll
            for (int bj = 0; bj < 2; ++bj) { v4u o0, o1;
                wave_xpose(scr, fr, fq, 4 + fq, __builtin_bit_cast(v4u, acc[ai][bj][m][0]), __builtin_bit_cast(v4u, acc[ai][bj][m][1]), lane, o0, o1);
#pragma unroll
                for (int h = 0; h < 2; ++h) { const v2u xq = xv[gi & 1][bj][h]; const f32x4 x1 = (f32x4){bf_lo(xq.x), bf_hi(xq.x), bf_lo(xq.y), bf_hi(xq.y)};
                    __builtin_nontemporal_store(x1 + __builtin_bit_cast(f32x4, h ? o1 : o0), (f32x4*)(out + xoff(ai, m, bj, h))); } }
        }
    }
};
}

DI void p0_tr_item(const float* W, int ldw, int ncol0, int K, const float* gain, float cscale, bf16* WT, int drow0, LAS float* scr, int kb, int lane) {
    const int k0 = 64 * kb;
    f32x4 wv_[8];
#pragma unroll
    for (int i = 0; i < 8; ++i) wv_[i] = __builtin_nontemporal_load((const f32x4*)(W + (size_t)(k0 + 8 * i + (lane >> 3)) * ldw + ncol0 + 4 * (lane & 7)));
#pragma unroll
    for (int i = 0; i < 8; ++i) { const int kk = 8 * i + (lane >> 3); const float gsc = (gain ? gain[k0 + kk] : 1.0f) * cscale; LAS float* d = scr + kk * 33 + 4 * (lane & 7);
        d[0] = wv_[i][0] * gsc; d[1] = wv_[i][1] * gsc; d[2] = wv_[i][2] * gsc; d[3] = wv_[i][3] * gsc; }
    LDS_WAIT(); asm volatile("" ::: "memory");
    const int c = lane & 7;
#pragma unroll
    for (int j = 0; j < 4; ++j) { const int n = (lane >> 3) + 8 * j; const LAS float* s = scr + (8 * c) * 33 + n;
        v4u o; o.x = pk2(s[0 * 33], s[1 * 33]); o.y = pk2(s[2 * 33], s[3 * 33]); o.z = pk2(s[4 * 33], s[5 * 33]); o.w = pk2(s[6 * 33], s[7 * 33]);
        *(v4u*)(WT + (size_t)(drow0 + n) * K + k0 + 8 * c) = o; }
    LDS_WAIT(); asm volatile("" ::: "memory");
}

DI void p0_phase(const Params& P, LAS unsigned char* lds, int wv, bool fill_wg, int it0, int it1, int r0, int r1, const float* xbase, int gwcu, int NCU) {
    int tid_ = (wv << 6) | lane_id(); asm volatile("" : "+v"(tid_)); const int tid = tid_, lane = tid & 63, wave = __builtin_amdgcn_readfirstlane(tid >> 6);
    unsigned char* ws = P.ws;
    const float* norm_a = P.in[8]; const float* w_in_a = P.in[9]; const float* b_gates = P.in[10]; const float* hnorm_a = P.in[11]; const float* w_out_a = P.in[12];
    const float* norm_kv = P.in[13]; const float* w_kv = P.in[14]; const float* norm_b = P.in[16]; const float* w_in_b = P.in[17]; const float* w_out_b = P.in[20];
    LAS float* WG = (LAS float*)(lds + 98304);
    if (fill_wg) { for (int i = tid; i < 8 * 1024; i += NTHR) { const int k = i >> 3, g = i & 7; WG[g * 1024 + k] = w_in_a[(size_t)k * WIN_LD + NP1 + g] * norm_a[k]; } }
    __syncthreads();
    LAS float* scr = (LAS float*)(lds + wave * 8704);
    const int gw = gwcu * 8 + wave, NGW = NCU * 8;
    constexpr int I_A = 16 * 320, I_OA = 32 * 32, I_2 = 16 * 160, I_OB = 8 * 32, NIT = I_A + I_OA + I_2 + I_OB;
    (void)NIT;
    for (int it = it0 + gw; it < it1; it += NGW) {
        int r = it;
        if (r < I_A) { const int kb = r / 320, nb = r % 320, n0 = 32 * nb; const float cs = (n0 >= 2048 && n0 < 4096) ? 0.04419417382415922f : 1.0f;
            { const int unit = n0 >> 8, l0 = n0 & 255, wc = l0 >> 6, bj = (l0 >> 5) & 1; const int drow = unit * 256 + 128 * bj + 32 * wc;
              p0_tr_item(w_in_a, WIN_LD, n0, 1024, norm_a, cs, (bf16*)(ws + WS_WA), drow, scr, kb, lane); } continue; } r -= I_A;
        if (r < I_OA) { const int kb = r / 32, nb = r % 32; p0_tr_item(w_out_a, 1024, 32 * nb, 2048, hnorm_a, 1.0f, (bf16*)(ws + WS_WOA), 32 * nb, scr, kb, lane); continue; } r -= I_OA;
        if (r < I_2) { const int kb = r / 160, nb = r % 160, n0 = 32 * nb; const int unit = n0 >> 8, l0 = n0 & 255, wc = l0 >> 6, bj = (l0 >> 5) & 1; const int drow = unit * 256 + 128 * bj + 32 * wc;
            if (n0 < 3072) p0_tr_item(w_kv, 3072, n0, 1024, norm_kv, 1.0f, (bf16*)(ws + WS_W2), drow, scr, kb, lane);
            else p0_tr_item(w_in_b, 2048, n0 - 3072, 1024, norm_b, 1.0f, (bf16*)(ws + WS_W2), drow, scr, kb, lane);
            continue; } r -= I_2;
        { const int kb = r / 32, nb = r % 32; p0_tr_item(w_out_b, 1024, 32 * nb, 512, nullptr, 1.0f, (bf16*)(ws + WS_WOB), 32 * nb, scr, kb, lane); }
    }
    bf16* XN = (bf16*)(ws + WS_XN); float* GATES = (float*)(ws + WS_GATES);
    f32x4 nx[2][4];
    auto rowload = [&](int mA, f32x4 (&dst)[2][4]) {
#pragma unroll
        for (int u = 0; u < 2; ++u) { int m = mA + u * NGW; if (m >= r1) m = mA;
            const float* xrow = xbase + (size_t)(m - r0) * D;
            const f32x4* xr = (const f32x4*)xrow + lane_id();
#pragma unroll
            for (int j = 0; j < 4; ++j) dst[u][j] = __builtin_nontemporal_load(xr + 64 * j); } };
    if (r0 + gw < r1) rowload(r0 + gw, nx);
    for (int m0 = r0 + gw; m0 < r1; m0 += 2 * NGW) {
        const int m1 = m0 + NGW; const bool has1 = m1 < r1;
        f32x4 v[2][4]; float s[2] = {0.f, 0.f};
#pragma unroll
        for (int u = 0; u < 2; ++u)
#pragma unroll
            for (int j = 0; j < 4; ++j) v[u][j] = nx[u][j];
        if (m0 + 2 * NGW < r1) rowload(m0 + 2 * NGW, nx);
#pragma unroll
        for (int u = 0; u < 2; ++u)
#pragma unroll
            for (int j = 0; j < 4; ++j) s[u] += (v[u][j][0] * v[u][j][0] + v[u][j][1] * v[u][j][1]) + (v[u][j][2] * v[u][j][2] + v[u][j][3] * v[u][j][3]);
        float ga[2][8];
#pragma unroll
        for (int g = 0; g < 8; ++g) {
#pragma unroll
            for (int u = 0; u < 2; ++u) ga[u][g] = 0.f;
#pragma unroll
            for (int j = 0; j < 4; ++j) { const f32x4 w = *(const LAS f32x4*)(WG + g * 1024 + 4 * lane + 256 * j);
#pragma unroll
                for (int u = 0; u < 2; ++u) ga[u][g] += (v[u][j][0] * w[0] + v[u][j][1] * w[1]) + (v[u][j][2] * w[2] + v[u][j][3] * w[3]); } }
#pragma unroll
        for (int o = 1; o < 16; o <<= 1) {
#pragma unroll
            for (int u = 0; u < 2; ++u) { s[u] += __shfl_xor(s[u], o);
#pragma unroll
                for (int g = 0; g < 8; ++g) ga[u][g] += __shfl_xor(ga[u][g], o); } }
#pragma unroll
        for (int u = 0; u < 2; ++u) { s[u] = xsum32(xsum16(s[u]));
#pragma unroll
            for (int g = 0; g < 8; ++g) ga[u][g] = xsum32(xsum16(ga[u][g])); }
#pragma unroll
        for (int u = 0; u < 2; ++u) { if (u == 1 && !has1) break; const int m = u ? m1 : m0;
            const float rnm = sqrtf(s[u] * (1.0f / D) + EPS); const float rstd = 1.0f / rnm;
            if (lane == 0) ((float*)(ws + WS_RNORM))[m] = rnm;
            unsigned long long* o8 = (unsigned long long*)(XN + (size_t)m * D) + lane;
#pragma unroll
            for (int j = 0; j < 4; ++j) o8[64 * j] = (unsigned long long)pk2(v[u][j][0] * rstd, v[u][j][1] * rstd) | ((unsigned long long)pk2(v[u][j][2] * rstd, v[u][j][3] * rstd) << 32);
            if (lane < 8) { float val = 0.f;
#pragma unroll
                for (int g = 0; g < 8; ++g) val = (lane == g) ? ga[u][g] : val;
                val = val * rstd + b_gates[lane];
                if (lane >= 4) val = fminf(val, 0.f) - log1pf(__expf(-fabsf(val)));
                GATES[(size_t)m * 8 + lane] = val; } }
    }
}

namespace scan {
#define TR4(r0, r1, r2, r3, base, o0, o1, o2, o3) asm volatile( \
    "ds_read_b64_tr_b16 %0, %4 offset:%5\n\tds_read_b64_tr_b16 %1, %4 offset:%6\n\tds_read_b64_tr_b16 %2, %4 offset:%7\n\tds_read_b64_tr_b16 %3, %4 offset:%8\n\ts_waitcnt lgkmcnt(0)" \
    : "=&v"(r0), "=&v"(r1), "=&v"(r2), "=&v"(r3) : "v"(base), "i"(o0), "i"(o1), "i"(o2), "i"(o3) : "memory")

DI bf16x8 cat8(s16x4 lo, s16x4 hi) { return __builtin_shufflevector(lo, hi, 0, 1, 2, 3, 4, 5, 6, 7); }

}
namespace scan2 {
constexpr int RING = 0;
constexpr int VSB = 98304;
constexpr int PS = 114688;
constexpr int SCAL = 122880;
constexpr int RS = 131072;
constexpr int QN = 131584;
constexpr int NVEC = 131840;
constexpr int NBF = 133888;
constexpr int LEND = 135936;
constexpr int ATILE = 136192;
constexpr int SSQ = 144384;
constexpr int LEND2 = 145408;
constexpr int OT = 145408, ZT = 153600;
constexpr int LEND3 = 161792;
constexpr int NINC = 161792;
constexpr int LEND4 = 162816;
static_assert(LEND4 <= LDS_BYTES - 32 && LEND + 16 <= ATILE, "scan2 LDS map");


#define SC2_STORE_TILE(cprev) do { if (!DRY) { const size_t rb_ = rowb + (size_t)(cprev) * 64; \
        _Pragma("unroll") for (int i_ = 0; i_ < 2; ++i_) { const int t_ = 16 * wave + (lane >> 3) + 8 * i_, k_ = lane & 7; \
            v4u v_ = *(const LAS v4u*)(lds + ATILE + t_ * 128 + ((k_ ^ ((t_ & 15) >> 1)) << 4)); if (t_ & 1) v_ = (v4u){v_.z, v_.w, v_.x, v_.y}; \
            *(v4u*)(A3 + (rb_ + t_) * DI_ + h * 512 + es * 64 + 8 * k_) = v_; } \
        if (lane < 16) { const int t_ = 16 * wave + lane; const LAS float* sq_ = (const LAS float*)(lds + SSQ); \
            HSS[(rb_ + t_) * 32 + h * 8 + es] = (sq_[t_] + sq_[64 + t_]) + (sq_[128 + t_] + sq_[192 + t_]); } } } while (0)
#ifndef SC2_NOPIN
#define SC2_W() do { asm volatile("s_waitcnt lgkmcnt(0)" ::: "memory"); __builtin_amdgcn_sched_barrier(0); } while (0)
#define SC2_SB() __builtin_amdgcn_sched_barrier(0)
#else
#define SC2_W() do {} while (0)
#define SC2_SB() do {} while (0)
#endif
DI int fsw(int r) { return ((r & 3) << 1) | ((r >> 2) & 1) | (r & 8); }
DI bf16x8 cat8(s16x4 lo, s16x4 hi) { return __builtin_shufflevector(lo, hi, 0, 1, 2, 3, 4, 5, 6, 7); }
#define SC2_BAR() do { asm volatile("" ::: "memory"); __builtin_amdgcn_s_barrier(); asm volatile("" ::: "memory"); } while (0)
#define TR2(r0, r1, base, o0, o1) asm volatile("ds_read_b64_tr_b16 %0, %2 offset:%3\n\tds_read_b64_tr_b16 %1, %2 offset:%4\n\ts_waitcnt lgkmcnt(0)" \
    : "=&v"(r0), "=&v"(r1) : "v"(base), "i"(o0), "i"(o1) : "memory")
#define TR8(r0, r1, r2, r3, r4, r5, r6, r7, b0, b1, b2, b3, o0, o1) asm volatile( \
    "ds_read_b64_tr_b16 %0, %8 offset:%12\n\tds_read_b64_tr_b16 %1, %8 offset:%13\n\tds_read_b64_tr_b16 %2, %9 offset:%12\n\tds_read_b64_tr_b16 %3, %9 offset:%13\n\t" \
    "ds_read_b64_tr_b16 %4, %10 offset:%12\n\tds_read_b64_tr_b16 %5, %10 offset:%13\n\tds_read_b64_tr_b16 %6, %11 offset:%12\n\tds_read_b64_tr_b16 %7, %11 offset:%13\n\ts_waitcnt lgkmcnt(0)" \
    : "=&v"(r0), "=&v"(r1), "=&v"(r2), "=&v"(r3), "=&v"(r4), "=&v"(r5), "=&v"(r6), "=&v"(r7) : "v"(b0), "v"(b1), "v"(b2), "v"(b3), "i"(o0), "i"(o1) : "memory")

#define TR8N(r0, r1, r2, r3, r4, r5, r6, r7, b0, b1, b2, b3, o0, o1) asm volatile( \
    "ds_read_b64_tr_b16 %0, %8 offset:%12\n\tds_read_b64_tr_b16 %1, %8 offset:%13\n\tds_read_b64_tr_b16 %2, %9 offset:%12\n\tds_read_b64_tr_b16 %3, %9 offset:%13\n\t" \
    "ds_read_b64_tr_b16 %4, %10 offset:%12\n\tds_read_b64_tr_b16 %5, %10 offset:%13\n\tds_read_b64_tr_b16 %6, %11 offset:%12\n\tds_read_b64_tr_b16 %7, %11 offset:%13" \
    : "=&v"(r0), "=&v"(r1), "=&v"(r2), "=&v"(r3), "=&v"(r4), "=&v"(r5), "=&v"(r6), "=&v"(r7) : "v"(b0), "v"(b1), "v"(b2), "v"(b3), "i"(o0), "i"(o1) : "memory")
#define WAIT8(r0, r1, r2, r3, r4, r5, r6, r7) do { asm volatile("s_waitcnt lgkmcnt(0)" : "+v"(r0), "+v"(r1), "+v"(r2), "+v"(r3), "+v"(r4), "+v"(r5), "+v"(r6), "+v"(r7) :: "memory"); __builtin_amdgcn_sched_barrier(0); } while (0)
template <int MODE>
DI void prompt_scan(const Params& P, LAS unsigned char* lds, int item, int wv) {
    constexpr bool DRY = MODE != 0, NO_C = MODE == 2 || MODE == 5 || MODE >= 6, NO_LOAD = MODE == 3 || MODE >= 8, NO_S = MODE == 4 || MODE == 2 || MODE >= 6, NO_EPI = MODE == 8;
    int tid_ = (wv << 6) | lane_id(); asm volatile("" : "+v"(tid_)); const int tid = tid_, lane = tid & 63, wave = __builtin_amdgcn_readfirstlane(tid >> 6);
    const int pair = (item & 7) * 4 + (item >> 6), es = (item >> 3) & 7;
    const int b = pair >> 2, h = pair & 3;
    const int qpair = (MODE == 7) ? 0 : ((MODE == 6) ? ((b * 4 + h + es * 4) & 31) : (b * 4 + h));
    unsigned char* ws = P.ws; float* out = P.out;
    const bf16* P1 = (const bf16*)(ws + WS_P1); const float* GATES = (const float*)(ws + WS_GATES);
    float* SCG = (float*)(ws + WS_SCALG) + (size_t)item * 64 * 1024;
    bf16* A3 = (bf16*)(ws + WS_A3); float* HSS = (float*)(ws + WS_HSS);
    const size_t rowb = (size_t)b * SEQ;
    const unsigned lbase = (unsigned)(uintptr_t)lds;

    __syncthreads();
    for (int i = tid; i < (LEND - PS) / 16; i += NTHR) *(LAS v4u*)(lds + PS + i * 16) = (v4u){0u, 0u, 0u, 0u};
    float m_final;
    {
        LAS float* TG = (LAS float*)(lds + 0); LAS float* TM = (LAS float*)(lds + 16384); LAS float* TMP = (LAS float*)(lds + 32768);
        float lf[8], ig[8];
#pragma unroll
        for (int k = 0; k < 8; ++k) { const float* gp = GATES + (rowb + tid * 8 + k) * 8; ig[k] = gp[h]; lf[k] = gp[4 + h]; }
        float g[8]; float run = 0.f;
#pragma unroll
        for (int k = 0; k < 8; ++k) { run += lf[k]; g[k] = run; }
        float x = run;
#pragma unroll
        for (int o = 1; o < 64; o <<= 1) { const float y = __shfl_up(x, o); if (lane >= o) x += y; }
        if (lane == 63) TMP[wave] = x;
        __syncthreads();
        float woff = 0.f;
        for (int w = 0; w < wave; ++w) woff += TMP[w];
        const float off = woff + x - run;
        float a[8]; float cm = -INFINITY;
#pragma unroll
        for (int k = 0; k < 8; ++k) { g[k] += off; cm = fmaxf(cm, ig[k] - g[k]); a[k] = cm; }
        float y = cm;
#pragma unroll
        for (int o = 1; o < 64; o <<= 1) { const float z = __shfl_up(y, o); if (lane >= o) y = fmaxf(y, z); }
        if (lane == 63) TMP[8 + wave] = y;
        __syncthreads();
        float pm = -INFINITY;
        for (int w = 0; w < wave; ++w) pm = fmaxf(pm, TMP[8 + w]);
        const float yprev = __shfl_up(y, 1); if (lane > 0) pm = fmaxf(pm, yprev);
        float mm[8];
#pragma unroll
        for (int k = 0; k < 8; ++k) { mm[k] = g[k] + fmaxf(0.f, fmaxf(pm, a[k])); TG[tid * 8 + k] = g[k]; TM[tid * 8 + k] = mm[k]; }
        __syncthreads();
        const int c = tid >> 3, t0 = c * 64;
        const float Gp = (c > 0) ? TG[t0 - 1] : 0.f, Mp = (c > 0) ? TM[t0 - 1] : 0.f, Gl = TG[t0 + 63], Ml = TM[t0 + 63];
        float* sc = SCG + (size_t)c * 1024;
#pragma unroll
        for (int k = 0; k < 8; ++k) { const int i = (tid & 7) * 8 + k;
            sc[i] = g[k] - mm[k]; sc[64 + i] = g[k] - ig[k]; sc[128 + i] = __expf(g[k] - Gp + Mp - mm[k]); sc[192 + i] = __expf(Gl - g[k] + ig[k] - Ml); sc[256 + i] = __expf(-mm[k]); }
        if ((tid & 7) == 0) sc[320] = __expf(Gl - Gp + Mp - Ml);
        m_final = TM[4095];
        if (tid == 0) *(LAS float*)(lds + LEND) = m_final;
        VM_WAIT();
        __syncthreads();
    }

#define SC2_GEOM() const int ln_ = lane_id(); const int x15 = ln_ & 15, g4 = ln_ >> 4, q4 = (ln_ & 15) >> 2, p4 = ln_ & 3, r31 = ln_ & 31, hh = ln_ >> 5; const int fx = fsw(x15); \
    unsigned ktrow[2]; int ktbase[2]; \
    _Pragma("unroll") for (int r2 = 0; r2 < 2; ++r2) { const int s15 = (8 * (g4 & 1) + q4 + 4 * r2) & 15; ktrow[r2] = (unsigned)((8 * g4 + q4 + 4 * r2) * 256 + 8 * (p4 & 1)); ktbase[r2] = (p4 >> 1) ^ fsw(s15); } \
    (void)r31; (void)hh; (void)fx; (void)ktrow; (void)ktbase; (void)x15;
    if (wave < 4) {
        const int e0 = 16 * wave;
        f32x4 C[32]; f32x4 Y[4];
#pragma unroll
        for (int i = 0; i < 32; ++i) C[i] = (f32x4){0.f, 0.f, 0.f, 0.f};
#pragma unroll
        for (int i = 0; i < 4; ++i) Y[i] = (f32x4){0.f, 0.f, 0.f, 0.f};
        bf16x8 Bw[2], Bwn[2];
        Bwn[0] = Bwn[1] = (bf16x8){0, 0, 0, 0, 0, 0, 0, 0};
        SC2_BAR();
        int slot = 0;
        for (int c = 0; c <= 64; ++c) {
            SC2_GEOM();
            const unsigned vfb = lbase + (unsigned)((8 * g4 + q4) * 128 + (e0 + 4 * p4) * 2);
            const size_t row0 = rowb + (size_t)(c - 1) * 64;
#pragma unroll
            for (int j = 0; j < 4; ++j) {
                if (j == 0 && !NO_EPI) {
                    if (c > 0) {
                        const LAS float* SCL = (const LAS float*)(lds + SCAL) + ((c - 1) & 1) * 1024;
                        const LAS float* RSp = (const LAS float*)(lds + RS); const LAS float* QNp = (const LAS float*)(lds + QN);
                        s16x4 vf[2][2];
                        { const unsigned vb = vfb + VSB + ((c - 1) & 1) * 8192;
                          asm volatile("ds_read_b64_tr_b16 %0, %4\n\tds_read_b64_tr_b16 %1, %4 offset:512\n\tds_read_b64_tr_b16 %2, %4 offset:4096\n\tds_read_b64_tr_b16 %3, %4 offset:4608"
                                       : "=&v"(vf[0][0]), "=&v"(vf[0][1]), "=&v"(vf[1][0]), "=&v"(vf[1][1]) : "v"(vb) : "memory"); }
#pragma unroll
                        for (int half = 0; half < 2; ++half) {
                            v2u ov[2], zv[2]; bf16x8 Bp[2][2]; float s_in[2], s_en[2], s_r0[2], s_r1[2], s_qn[2];
#pragma unroll
                            for (int u = 0; u < 2; ++u) { const int t = 16 * (2 * half + u) + x15; const int lo_ = t * 128 + (((2 * wave + (g4 >> 1)) ^ (t & 7)) << 4) + 8 * (g4 & 1);
                                ov[u] = *(const LAS v2u*)(lds + OT + lo_); zv[u] = *(const LAS v2u*)(lds + ZT + lo_);
#pragma unroll
                                for (int ks2 = 0; ks2 < 2; ++ks2) Bp[u][ks2] = *(const LAS bf16x8*)(lds + PS + t * 128 + (((4 * ks2 + g4) ^ (t & 7)) << 4));
                                s_in[u] = SCL[128 + t]; s_en[u] = SCL[256 + t]; s_r0[u] = RSp[t]; s_r1[u] = RSp[64 + t]; s_qn[u] = QNp[t]; }
                            asm volatile("s_waitcnt lgkmcnt(0)" : "+v"(vf[0][0]), "+v"(vf[0][1]), "+v"(vf[1][0]), "+v"(vf[1][1]) :: "memory");
                            __builtin_amdgcn_sched_barrier(0);
                            f32x4 Yi[2];
#pragma unroll
                            for (int u = 0; u < 2; ++u) { Yi[u] = (f32x4){0.f, 0.f, 0.f, 0.f};
#pragma unroll
                                for (int ks2 = 0; ks2 < 2; ++ks2) Yi[u] = MFMA16(cat8(vf[ks2][0], vf[ks2][1]), Bp[u][ks2], Yi[u]); }
#pragma unroll
                            for (int u = 0; u < 2; ++u) { const int tt = 2 * half + u, t = 16 * tt + x15;
                                const float inter = s_in[u];
                                const float den = s_r0[u] + s_r1[u] + inter * s_qn[u];
                                const float rden = __builtin_amdgcn_rcpf(fmaxf(fabsf(den), s_en[u]));
                                float hv[4]; float ssq = 0.f;
#pragma unroll
                                for (int r = 0; r < 4; ++r) { hv[r] = (Yi[u][r] + inter * Y[tt][r]) * rden; ssq += hv[r] * hv[r]; }
                                const float o0 = bf_lo(ov[u].x), o1 = bf_hi(ov[u].x), o2 = bf_lo(ov[u].y), o3 = bf_hi(ov[u].y);
                                const float z0 = bf_lo(zv[u].x), z1 = bf_hi(zv[u].x), z2 = bf_lo(zv[u].y), z3 = bf_hi(zv[u].y);
                                v2u w; w.x = pk2(hv[0] * fgate(o0, z0), hv[1] * fgate(o1, z1));
                                w.y = pk2(hv[2] * fgate(o2, z2), hv[3] * fgate(o3, z3));
                                *(LAS v2u*)(lds + ATILE + t * 128 + (((4 * wave + g4) ^ (t & 15)) << 3)) = w;
                                ssq = xsum32(xsum16(ssq));
                                if (g4 == 0) ((LAS float*)(lds + SSQ))[wave * 64 + t] = ssq;
                                Y[tt] = (f32x4){0.f, 0.f, 0.f, 0.f}; }
                        }
                    }
                    if (c < 64) {
                        const LAS float* SCL = (const LAS float*)(lds + SCAL) + (c & 1) * 1024;
                        s16x4 vf[2][2]; f32x4 wq[2][2];
                        { const unsigned vb = vfb + VSB + (c & 1) * 8192;
                          asm volatile("ds_read_b64_tr_b16 %0, %4\n\tds_read_b64_tr_b16 %1, %4 offset:512\n\tds_read_b64_tr_b16 %2, %4 offset:4096\n\tds_read_b64_tr_b16 %3, %4 offset:4608"
                                       : "=&v"(vf[0][0]), "=&v"(vf[0][1]), "=&v"(vf[1][0]), "=&v"(vf[1][1]) : "v"(vb) : "memory"); }
#pragma unroll
                        for (int ks2 = 0; ks2 < 2; ++ks2) { wq[ks2][0] = *(const LAS f32x4*)(SCL + 192 + 32 * ks2 + 8 * g4); wq[ks2][1] = *(const LAS f32x4*)(SCL + 192 + 32 * ks2 + 8 * g4 + 4); }
                        asm volatile("s_waitcnt lgkmcnt(0)" : "+v"(vf[0][0]), "+v"(vf[0][1]), "+v"(vf[1][0]), "+v"(vf[1][1]) :: "memory");
                        __builtin_amdgcn_sched_barrier(0);
#pragma unroll
                        for (int ks2 = 0; ks2 < 2; ++ks2) { const f32x4 w0 = wq[ks2][0], w1 = wq[ks2][1];
                            const v4u raw = __builtin_bit_cast(v4u, cat8(vf[ks2][0], vf[ks2][1])); v4u o;
                            o.x = pk2(bf_lo(raw.x) * w0[0], bf_hi(raw.x) * w0[1]); o.y = pk2(bf_lo(raw.y) * w0[2], bf_hi(raw.y) * w0[3]);
                            o.z = pk2(bf_lo(raw.z) * w1[0], bf_hi(raw.z) * w1[1]); o.w = pk2(bf_lo(raw.w) * w1[2], bf_hi(raw.w) * w1[3]);
                            Bw[ks2] = __builtin_bit_cast(bf16x8, o);
                            v4u on = (v4u){pk2(w0[0], w0[1]), pk2(w0[2], w0[3]), pk2(w1[0], w1[1]), pk2(w1[2], w1[3])}; if (x15 != 0) on = (v4u){0u, 0u, 0u, 0u}; Bwn[ks2] = __builtin_bit_cast(bf16x8, on); }
                    }
                }
                if (j == 1 && c > 0) SC2_STORE_TILE(c - 1);
                if (c < 64 && !NO_C) {
                    const LAS unsigned char* QSL = lds + RING + slot * 32768; const unsigned ksl = lbase + RING + slot * 32768 + 16384;
                    const float decay = ((const LAS float*)(lds + SCAL))[(c & 1) * 1024 + 320];
#pragma unroll
                    for (int kb = 0; kb < 2; ++kb) {
                        s16x4 lo[2][4], hi[2][4];
                        { const unsigned qb_ = lbase + RING + slot * 32768 + (unsigned)(x15 * 256 + 8 * (g4 & 1));
#pragma unroll
                          for (int k2 = 0; k2 < 2; ++k2) { const int ks = 2 * kb + k2;
                            const unsigned bl_ = qb_ + (unsigned)(((4 * ks + (g4 >> 1)) ^ fx) << 4), bh_ = qb_ + (unsigned)(((4 * ks + 2 + (g4 >> 1)) ^ fx) << 4);
                            asm volatile("ds_read_b64 %0, %8\n\tds_read_b64 %1, %8 offset:4096\n\tds_read_b64 %2, %8 offset:8192\n\tds_read_b64 %3, %8 offset:12288\n\t"
                                         "ds_read_b64 %4, %9\n\tds_read_b64 %5, %9 offset:4096\n\tds_read_b64 %6, %9 offset:8192\n\tds_read_b64 %7, %9 offset:12288"
                                         : "=&v"(lo[k2][0]), "=&v"(lo[k2][1]), "=&v"(lo[k2][2]), "=&v"(lo[k2][3]), "=&v"(hi[k2][0]), "=&v"(hi[k2][1]), "=&v"(hi[k2][2]), "=&v"(hi[k2][3]) : "v"(bl_), "v"(bh_) : "memory"); } }
                        bf16x8 A[2];
#pragma unroll
                        for (int k2 = 0; k2 < 2; ++k2) { const int ks = 2 * kb + k2; const f32x4 c0 = C[8 * j + 2 * ks], c1 = C[8 * j + 2 * ks + 1];
                            v4u ap; ap.x = pk2(c0[0], c0[1]); ap.y = pk2(c0[2], c0[3]); ap.z = pk2(c1[0], c1[1]); ap.w = pk2(c1[2], c1[3]); A[k2] = __builtin_bit_cast(bf16x8, ap); }
                        asm volatile("s_waitcnt lgkmcnt(0)" : "+v"(lo[0][0]), "+v"(lo[0][1]), "+v"(lo[0][2]), "+v"(lo[0][3]), "+v"(hi[0][0]), "+v"(hi[0][1]), "+v"(hi[0][2]), "+v"(hi[0][3]),
                                     "+v"(lo[1][0]), "+v"(lo[1][1]), "+v"(lo[1][2]), "+v"(lo[1][3]), "+v"(hi[1][0]), "+v"(hi[1][1]), "+v"(hi[1][2]), "+v"(hi[1][3]) :: "memory");
                        __builtin_amdgcn_sched_barrier(0);
#pragma unroll
                        for (int k2 = 0; k2 < 2; ++k2)
#pragma unroll
                            for (int tt = 0; tt < 4; ++tt) Y[tt] = MFMA16(A[k2], cat8(lo[k2][tt], hi[k2][tt]), Y[tt]);
                        SC2_SB();
                    }
#pragma unroll
                    for (int dq = 0; dq < 2; ++dq) {
                        s16x4 ka[2][2][2][2];
#pragma unroll
                        for (int u = 0; u < 2; ++u) { const int dp = 2 * dq + u;
                            const unsigned b00 = ksl + ktrow[0] + (unsigned)(((ktbase[0]) ^ (2 * (2 * dp))) << 4), b01 = ksl + ktrow[1] + (unsigned)(((ktbase[1]) ^ (2 * (2 * dp))) << 4);
                            const unsigned b10 = ksl + ktrow[0] + (unsigned)(((ktbase[0]) ^ (2 * (2 * dp + 1))) << 4), b11 = ksl + ktrow[1] + (unsigned)(((ktbase[1]) ^ (2 * (2 * dp + 1))) << 4);
                            TR8N(ka[u][0][0][0], ka[u][0][0][1], ka[u][0][1][0], ka[u][0][1][1], ka[u][1][0][0], ka[u][1][0][1], ka[u][1][1][0], ka[u][1][1][1], b00, b01, b10, b11, 0, 8192); }
                        const bool mine = (wave >> 1) == dq;

                        asm volatile("s_waitcnt lgkmcnt(0)" : "+v"(ka[0][0][0][0]), "+v"(ka[0][0][0][1]), "+v"(ka[0][0][1][0]), "+v"(ka[0][0][1][1]), "+v"(ka[0][1][0][0]), "+v"(ka[0][1][0][1]), "+v"(ka[0][1][1][0]), "+v"(ka[0][1][1][1]),
                                     "+v"(ka[1][0][0][0]), "+v"(ka[1][0][0][1]), "+v"(ka[1][0][1][0]), "+v"(ka[1][0][1][1]), "+v"(ka[1][1][0][0]), "+v"(ka[1][1][0][1]), "+v"(ka[1][1][1][0]), "+v"(ka[1][1][1][1]) :: "memory");
                        __builtin_amdgcn_sched_barrier(0);
#pragma unroll
                        for (int u = 0; u < 2; ++u)
#pragma unroll
                            for (int d2 = 0; d2 < 2; ++d2) { const int T = 8 * j + 2 * (2 * dq + u) + d2; f32x4 cc = C[T] * decay;
#pragma unroll
                                for (int ks2 = 0; ks2 < 2; ++ks2) cc = MFMA16(cat8(ka[u][d2][0][ks2], ka[u][d2][1][ks2]), Bw[ks2], cc);
                                C[T] = cc; }
                        if (mine) {
#pragma unroll
                            for (int u = 0; u < 2; ++u) { if ((wave & 1) != u) continue;
#pragma unroll
                                for (int d2 = 0; d2 < 2; ++d2) { f32x4 nn = (f32x4){0.f, 0.f, 0.f, 0.f};
#pragma unroll
                                    for (int ks2 = 0; ks2 < 2; ++ks2) nn = MFMA16(cat8(ka[u][d2][0][ks2], ka[u][d2][1][ks2]), Bwn[ks2], nn);
                                    if (x15 == 0) *(LAS f32x4*)(lds + NINC + (j & 1) * 512 + (32 * wave + 16 * d2 + 4 * g4) * 4) = nn; } } }
                    }
                }
                asm volatile("s_waitcnt lgkmcnt(0)" ::: "memory");
                SC2_BAR();
                slot = (slot == 2) ? 0 : slot + 1;
                if (c == 64) break;
            }
        }
        SC2_STORE_TILE(63);
        { int ln2 = lane; asm volatile("" : "+v"(ln2)); const int xo = ln2 & 15, go = ln2 >> 4;
          float* cp = out + O_CP + ((size_t)(b * NH + h) * DH + 4 * go) * DH + es * 64 + e0 + xo;
#pragma unroll
        for (int T = 0; T < 32; ++T)
#pragma unroll
            for (int r = 0; r < 4; ++r) { if (!DRY) cp[(size_t)(16 * T + r) * DH] = C[T][r]; else asm volatile("" :: "v"(C[T][r])); } }
    } else {
        const int sw = wave - 4;
        const int tt = (sw == 0) ? 0 : 1, st = (sw == 2) ? 1 : 0;
        f32x16 Racc; float dmv[4][4];
#pragma unroll
        for (int g = 0; g < 4; ++g)
#pragma unroll
            for (int jj = 0; jj < 4; ++jj) dmv[g][jj] = 0.f;
#pragma unroll
        for (int r = 0; r < 16; ++r) Racc[r] = 0.f;
        unsigned srcq[4]; unsigned srcv[2]; unsigned srco[2];
        { const int x15 = lane & 15, g4 = lane >> 4;
#pragma unroll
        for (int i = 0; i < 4; ++i) { const int row = 4 * (4 * sw + i) + g4; srcq[i] = (unsigned)(row * 128 + 8 * (x15 ^ fsw(row & 15))); }
#pragma unroll
        for (int i = 0; i < 2; ++i) { const int row = 8 * (2 * sw + i) + (lane >> 3); srco[i] = (unsigned)(row * 64 + 8 * ((lane & 7) ^ (row & 7))); }
#pragma unroll
        for (int i = 0; i < 2; ++i) srcv[i] = (unsigned)(512 * (2 * sw + i) + 8 * lane);
        }
#define SC2_GLDS(src, dstoff) __builtin_amdgcn_global_load_lds((const unsigned*)(src), (LAS unsigned*)(lds + (dstoff)), 16, 0, 0)
#define SC2_ISSUE_SLAB(gidx, slt) do { const int g_ = (gidx) < 255 ? (gidx) : 255; const bf16* qb = P1 + ((size_t)g_ * 32 + qpair) * 16384; const bf16* kb = qb + 8192; \
        _Pragma("unroll") for (int i_ = 0; i_ < 4; ++i_) { SC2_GLDS(qb + srcq[i_], RING + (slt) * 32768 + 1024 * (4 * sw + i_)); SC2_GLDS(kb + srcq[i_], RING + (slt) * 32768 + 16384 + 1024 * (4 * sw + i_)); } } while (0)
#define SC2_ISSUE_VS(cidx) do { const int c_ = (cidx) < 63 ? (cidx) : 63; const bf16* vb_ = P1 + P1_V + (((size_t)c_ * 32 + (b * 4 + h)) * 8 + es) * 4096; \
        _Pragma("unroll") for (int i_ = 0; i_ < 2; ++i_) SC2_GLDS(vb_ + srcv[i_], VSB + ((cidx) & 1) * 8192 + 1024 * (2 * sw + i_)); \
        SC2_GLDS(SCG + (size_t)c_ * 1024 + 256 * sw + 4 * lane, SCAL + ((cidx) & 1) * 4096 + 1024 * sw); } while (0)
#define SC2_ISSUE_OZ(cidx) do { const bf16* ob_ = P1 + P1_V + P1_PART + (((size_t)(cidx) * 32 + (b * 4 + h)) * 8 + es) * 4096; \
        _Pragma("unroll") for (int i_ = 0; i_ < 2; ++i_) { SC2_GLDS(ob_ + srco[i_], OT + 1024 * (2 * sw + i_)); SC2_GLDS(ob_ + P1_PART + srco[i_], ZT + 1024 * (2 * sw + i_)); } } while (0)
        SC2_ISSUE_VS(0);
        SC2_ISSUE_SLAB(0, 0);
        SC2_ISSUE_SLAB(1, 1);
        asm volatile("s_waitcnt vmcnt(8) lgkmcnt(0)" ::: "memory");
        SC2_BAR();
        int slot = 0;
        for (int c = 0; c <= 64; ++c) {
            SC2_GEOM();
            const LAS float* SCL = (const LAS float*)(lds + SCAL) + (c & 1) * 1024;
#pragma unroll
            for (int j = 0; j < 4; ++j) {
                if (sw == 3 && (c > 0 || j > 0) && ln_ < 32) {
                    const int cp = (j == 0) ? c - 1 : c, jp = (j == 0) ? 3 : j - 1;
                    const float dcy = ((const LAS float*)(lds + SCAL))[(cp & 1) * 1024 + 320];
                    LAS float* NVp = (LAS float*)(lds + NVEC) + 128 * jp + 4 * ln_;
                    const f32x4 nv = *(const LAS f32x4*)NVp * dcy + *(const LAS f32x4*)(lds + NINC + (jp & 1) * 512 + 16 * ln_);
                    *(LAS f32x4*)NVp = nv;
                    v2u w; w.x = pk2(nv[0], nv[1]); w.y = pk2(nv[2], nv[3]); *(LAS v2u*)(lds + NBF + ((cp + 1) & 1) * 1024 + (128 * jp + 4 * ln_) * 2) = w; }
                if (c < 64) {
                    const int s2 = (slot == 0) ? 2 : slot - 1;
                    if (!NO_LOAD) { SC2_ISSUE_SLAB(4 * c + j + 2, s2);
                    if (j == 1) SC2_ISSUE_VS(c + 1);
                    if (j == 2) SC2_ISSUE_OZ(c); }
                    const LAS unsigned char* QSL = lds + RING + slot * 32768; const LAS unsigned char* KSL = QSL + 16384;
                    if (!NO_S) {
                    if (sw < 3) {
                        const int ra = 32 * st + r31, rb = 32 * tt + r31;
                        { bf16x8 Af[8], Bf[8];
#pragma unroll
                            for (int ks = 0; ks < 8; ++ks) { Af[ks] = *(const LAS bf16x8*)(KSL + ra * 256 + (((2 * ks + hh) ^ fx) << 4)); Bf[ks] = *(const LAS bf16x8*)(QSL + rb * 256 + (((2 * ks + hh) ^ fx) << 4)); }
                            SC2_W();
#pragma unroll
                            for (int ks = 0; ks < 8; ++ks) Racc = MFMA32(Af[ks], Bf[ks], Racc);
                            SC2_SB(); }
                        if (j == 2) {
                            const int t = 32 * tt + r31; const float At = SCL[t]; f32x4 Bs[4];
#pragma unroll
                            for (int g = 0; g < 4; ++g) Bs[g] = *(const LAS f32x4*)(SCL + 64 + 32 * st + 8 * g + 4 * hh);
                            SC2_W();
#pragma unroll
                            for (int g = 0; g < 4; ++g)
#pragma unroll
                                for (int jj = 0; jj < 4; ++jj) { const int s = 32 * st + 8 * g + 4 * hh + jj; const float ev = __builtin_amdgcn_exp2f((At - Bs[g][jj]) * 1.4426950408889634f); dmv[g][jj] = (s <= t) ? ev : 0.f; } }
                    } else {
                        f32x4 qa[4];
#pragma unroll
                        for (int t16 = 0; t16 < 4; ++t16) qa[t16] = (f32x4){Racc[4 * t16], Racc[4 * t16 + 1], Racc[4 * t16 + 2], Racc[4 * t16 + 3]};
                        { bf16x8 Bn[4], Aq[4][4];
#pragma unroll
                            for (int ks = 0; ks < 4; ++ks) { Bn[ks] = *(const LAS bf16x8*)(lds + NBF + (c & 1) * 1024 + (128 * j + 32 * ks + 8 * g4) * 2);
#pragma unroll
                                for (int t16 = 0; t16 < 4; ++t16) Aq[ks][t16] = *(const LAS bf16x8*)(QSL + (16 * t16 + x15) * 256 + (((4 * ks + g4) ^ fx) << 4)); }
                            SC2_W();
#pragma unroll
                            for (int ks = 0; ks < 4; ++ks) { if (x15 != 0) Bn[ks] = (bf16x8){0, 0, 0, 0, 0, 0, 0, 0};
#pragma unroll
                                for (int t16 = 0; t16 < 4; ++t16) qa[t16] = MFMA16(Aq[ks][t16], Bn[ks], qa[t16]); }
                            SC2_SB(); }
#pragma unroll
                        for (int t16 = 0; t16 < 4; ++t16) { Racc[4 * t16] = qa[t16][0]; Racc[4 * t16 + 1] = qa[t16][1]; Racc[4 * t16 + 2] = qa[t16][2]; Racc[4 * t16 + 3] = qa[t16][3]; }
                    }
                    if (j == 3) {
                        if (sw < 3) {
                            const int t = 32 * tt + r31; float rsum = 0.f;
#pragma unroll
                            for (int g = 0; g < 4; ++g) { float pv[4];
#pragma unroll
                                for (int jj = 0; jj < 4; ++jj) { pv[jj] = Racc[4 * g + jj] * dmv[g][jj]; rsum += pv[jj]; }
                                v2u w; w.x = pk2(pv[0], pv[1]); w.y = pk2(pv[2], pv[3]);
                                *(LAS v2u*)(lds + PS + t * 128 + (((4 * st + g) ^ (t & 7)) << 4) + 8 * hh) = w; }
                            rsum = xsum32(rsum);
                            if (hh == 0) ((LAS float*)(lds + RS))[st * 64 + t] = rsum;
                        } else if (x15 == 0) {
#pragma unroll
                            for (int t16 = 0; t16 < 4; ++t16)
#pragma unroll
                                for (int r = 0; r < 4; ++r) ((LAS float*)(lds + QN))[16 * t16 + 4 * g4 + r] = Racc[4 * t16 + r];
                        }
#pragma unroll
                        for (int r = 0; r < 16; ++r) Racc[r] = 0.f;
                    }
                    }
                }
                if (c < 64) { if (j == 1) asm volatile("s_waitcnt vmcnt(11) lgkmcnt(0)" ::: "memory"); else if (j == 2) asm volatile("s_waitcnt vmcnt(12) lgkmcnt(0)" ::: "memory"); else asm volatile("s_waitcnt vmcnt(8) lgkmcnt(0)" ::: "memory"); }
                else asm volatile("s_waitcnt vmcnt(0) lgkmcnt(0)" ::: "memory");
                SC2_BAR();
                slot = (slot == 2) ? 0 : slot + 1;
                if (c == 64) break;
            }
        }
    }
    __syncthreads();
    { const int tid2 = (wv << 6) | lane_id();
      if (!DRY && es == 0) { out[O_NP + (size_t)(b * NH + h) * DH + tid2] = ((const LAS float*)(lds + NVEC))[tid2]; if (tid2 == 0) out[O_MP + b * NH + h] = *(const LAS float*)(lds + LEND); } }
    __syncthreads();
}
}

namespace sscan {
constexpr int QT = 0;
constexpr int KT = 16384;
constexpr int V8 = 32768;
constexpr int SM_ = 34816;
constexpr int SCV = 35072;
constexpr int RED = 36864;
constexpr int N0 = 53248;
DI void sample_item(const Params& P, LAS unsigned char* lds, int item, int wv) {
    int tid_ = (wv << 6) | lane_id(); asm volatile("" : "+v"(tid_)); const int tid = tid_, lane = tid & 63, wave = __builtin_amdgcn_readfirstlane(tid >> 6);
    const int es = item & 7, h = (item >> 3) & 3, b = item >> 5;
    unsigned char* ws = P.ws; float* out = P.out;
    const bf16* P1 = (const bf16*)(ws + WS_P1); const float* GATES = (const float*)(ws + WS_GATES);
    bf16* A3 = (bf16*)(ws + WS_A3); float* HSS = (float*)(ws + WS_HSS);
    const size_t row0 = (size_t)TP + b * 8;
    const bf16* P1S = P1 + P1_S + (size_t)(b * 8) * NP1;
    const float* C0 = P.in[2] + (size_t)(b * NH + h) * DH * DH; const float* n0 = P.in[3] + (size_t)(b * NH + h) * DH; const float m0 = P.in[4][b * NH + h];
    LAS float* qT = (LAS float*)(lds + QT); LAS float* kT = (LAS float*)(lds + KT); LAS float* v8 = (LAS float*)(lds + V8);
    LAS float* Sm = (LAS float*)(lds + SM_); LAS float* scv = (LAS float*)(lds + SCV); LAS float* red = (LAS float*)(lds + RED); LAS float* nn = (LAS float*)(lds + N0);
    const int dg = tid >> 4, e4 = tid & 15;
    f32x4 cin[16];
#pragma unroll
    for (int dd = 0; dd < 16; ++dd) cin[dd] = __builtin_nontemporal_load((const f32x4*)(C0 + (size_t)(dg * 16 + dd) * DH + es * 64 + 4 * e4));
    __syncthreads();
    float bcum[8], mt[8], ig[8]; float run = 0.f;
#pragma unroll
    for (int t = 0; t < 8; ++t) { const float* gp = GATES + (row0 + t) * 8; ig[t] = gp[h]; run += gp[4 + h]; bcum[t] = run; }
#pragma unroll
    for (int t = 0; t < 8; ++t) { float mx = bcum[t] + m0;
#pragma unroll
        for (int s = 0; s < 8; ++s) if (s <= t) mx = fmaxf(mx, bcum[t] - bcum[s] + ig[s]);
        mt[t] = mx; }
    const float mnew = mt[7]; const float decay = __expf(bcum[7] + m0 - mnew);
    float wsv[8];
#pragma unroll
    for (int s = 0; s < 8; ++s) wsv[s] = __expf(bcum[7] - bcum[s] + ig[s] - mnew);
    { const int d = tid;
#pragma unroll
        for (int t = 0; t < 8; ++t) { const float qv = bf_lo((unsigned)P1S[(size_t)t * NP1 + h * 512 + d]); const float kv = bf_lo((unsigned)P1S[(size_t)t * NP1 + 2048 + h * 512 + d]);
            qT[d * 8 + t] = qv; kT[d * 8 + t] = kv; }
        nn[d] = n0[d];
        const int t = tid >> 6, e = tid & 63; v8[t * 64 + e] = bf_lo((unsigned)P1S[(size_t)t * NP1 + 4096 + h * 512 + es * 64 + e]); }
    __syncthreads();
    { const int t = wave; float acc[9];
#pragma unroll
        for (int s = 0; s < 9; ++s) acc[s] = 0.f;
#pragma unroll
        for (int i = 0; i < 8; ++i) { const int d = lane + 64 * i; const float qv = qT[d * 8 + t];
#pragma unroll
            for (int s = 0; s < 8; ++s) acc[s] += qv * kT[d * 8 + s];
            acc[8] += qv * nn[d]; }
#pragma unroll
        for (int s = 0; s < 9; ++s) acc[s] = wave_sum(acc[s]);
        if (lane < 8) { float val = 0.f;
#pragma unroll
            for (int s = 0; s < 8; ++s) val = (lane == s) ? acc[s] : val;
            const int s = lane; float bt = 0.f, bs = 0.f, igs = 0.f, mtt = 0.f;
#pragma unroll
            for (int u = 0; u < 8; ++u) { bt = (u == t) ? bcum[u] : bt; mtt = (u == t) ? mt[u] : mtt; bs = (u == s) ? bcum[u] : bs; igs = (u == s) ? ig[u] : igs; }
            Sm[t * 8 + s] = (s <= t) ? val * __expf(bt - bs + igs - mtt) : 0.f;
            if (lane == 0) { scv[t] = __expf(bt + m0 - mtt); scv[8 + t] = __expf(-mtt); scv[16 + t] = acc[8]; } }
    }
    __syncthreads();
    { const int d = tid;
#pragma unroll
        for (int s = 0; s < 8; ++s) kT[d * 8 + s] *= wsv[s]; }
    __syncthreads();
    f32x4 acc[8];
#pragma unroll
    for (int t = 0; t < 8; ++t) acc[t] = (f32x4){0.f, 0.f, 0.f, 0.f};
    f32x4 vv[8];
#pragma unroll
    for (int s = 0; s < 8; ++s) vv[s] = *(const LAS f32x4*)(v8 + s * 64 + 4 * e4);
    float* Cout = out + O_CS + (size_t)(b * NH + h) * DH * DH;
#pragma unroll
    for (int dd = 0; dd < 16; ++dd) { const int d = dg * 16 + dd;
        const f32x4 c = cin[dd];
        const f32x4 q0 = *(const LAS f32x4*)(qT + d * 8), q1 = *(const LAS f32x4*)(qT + d * 8 + 4);
        const f32x4 k0 = *(const LAS f32x4*)(kT + d * 8), k1 = *(const LAS f32x4*)(kT + d * 8 + 4);
        acc[0] += c * q0[0]; acc[1] += c * q0[1]; acc[2] += c * q0[2]; acc[3] += c * q0[3]; acc[4] += c * q1[0]; acc[5] += c * q1[1]; acc[6] += c * q1[2]; acc[7] += c * q1[3];
        f32x4 cn = c * decay;
        cn += vv[0] * k0[0]; cn += vv[1] * k0[1]; cn += vv[2] * k0[2]; cn += vv[3] * k0[3]; cn += vv[4] * k1[0]; cn += vv[5] * k1[1]; cn += vv[6] * k1[2]; cn += vv[7] * k1[3];
        __builtin_nontemporal_store(cn, (f32x4*)(Cout + (size_t)d * DH + es * 64 + 4 * e4)); }
#pragma unroll
    for (int t = 0; t < 8; ++t)
#pragma unroll
        for (int j = 0; j < 4; ++j) { acc[t][j] = xsum32(xsum16(acc[t][j])); }
    if (lane < 16) {
#pragma unroll
        for (int t = 0; t < 8; ++t) *(LAS f32x4*)(red + (wave * 8 + t) * 64 + 4 * e4) = acc[t]; }
    __syncthreads();
    { const int t = tid >> 6, e = tid & 63;
        float yin = 0.f;
#pragma unroll
        for (int w = 0; w < 8; ++w) yin += red[(w * 8 + t) * 64 + e];
        float num = 0.f, den = 0.f;
#pragma unroll
        for (int s = 0; s < 8; ++s) { const float sv = Sm[t * 8 + s]; num += sv * v8[s * 64 + e]; den += sv; }
        const float inter = scv[t]; num += inter * yin; den += inter * scv[16 + t];
        const float hv = num / fmaxf(fabsf(den), scv[8 + t]);
        const size_t row = row0 + t;
        const float ov = bf_lo((unsigned)P1S[(size_t)t * NP1 + 6144 + h * 512 + es * 64 + e]), zv = bf_lo((unsigned)P1S[(size_t)t * NP1 + 8192 + h * 512 + es * 64 + e]);
        A3[row * DI_ + h * 512 + es * 64 + e] = (bf16)f2bf(hv * fgate(ov, zv));
        const float ssq = wave_sum(hv * hv);
        if (lane == 0) HSS[row * 32 + h * 8 + es] = ssq;
    }
    if (es == 0) { const int d = tid; float a = nn[d] * decay;
#pragma unroll
        for (int s = 0; s < 8; ++s) a += kT[d * 8 + s];
        out[O_NS + (size_t)(b * NH + h) * DH + d] = a; if (tid == 0) out[O_MS + b * NH + h] = mnew; }
}
}

DI int t5_bucket(int dist) {
    if (dist < 16) return dist;
    const float d = (float)dist;
    const int large = 16 + (int)(logf(d / 16.0f) / 4.852030263919617f * 16.0f);
    return large < 31 ? large : 31;
}
namespace attn {
constexpr int KS = 0, VS = 32768, BIAS = 65536;
constexpr int NITEMS = BATCH * NQH * 32;
struct ItemGeo { int head, b, dil, rcl, nb; size_t rowb; };
DI ItemGeo item_geo(int item) {
    ItemGeo g; const int cb = item & 31; g.head = (item >> 5) % NQH; g.b = item / (32 * NQH);
    const int grp = g.head >> 3; g.dil = grp == 0 ? 1 : (grp == 1 ? 4 : 16); const int nbk = 32 / g.dil;
    g.rcl = cb / nbk; g.nb = cb % nbk; g.rowb = (size_t)g.b * SEQ; return g;
}
struct ItemRegs { v4u k[2], v[2]; bf16x8 q[2]; float bias; };
constexpr int KBLK = 32768;
constexpr int ABIAS = 3 * KBLK;
DI void blk_load(v4u (&k)[2], v4u (&v)[2], const Params& P, const ItemGeo& g, int blk, int tid) {
    const size_t boff = ((size_t)(g.b * NQH + g.head) * SEQ + (size_t)g.rcl * (SEQ / g.dil) + blk * 128) * 64;
    const bf16* KP = (const bf16*)(P.ws + WS_KP) + boff; const bf16* VP = (const bf16*)(P.ws + WS_VP) + boff;
#pragma unroll
    for (int i = 0; i < 2; ++i) { const int L = i * NTHR + tid;
        k[i] = __builtin_nontemporal_load((const v4u*)(KP + L * 8)); v[i] = __builtin_nontemporal_load((const v4u*)(VP + L * 8)); }
}
DI void blk_store(const v4u (&k)[2], const v4u (&v)[2], LAS unsigned char* slot, int tid) {
#pragma unroll
    for (int i = 0; i < 2; ++i) { const int L = i * NTHR + tid, kj = L >> 3, ch = L & 7;
        *(LAS v4u*)(slot + kj * 128 + ((ch ^ (kj & 7)) << 4)) = k[i]; *(LAS v4u*)(slot + 16384 + kj * 128 + ((ch ^ (2 * ((kj >> 1) & 3))) << 4)) = v[i]; }
}
DI void item_load(ItemRegs& R, const Params& P, const ItemGeo& g, int tid, int wave, int x15, int G4) {
    const bf16* KVQZ = (const bf16*)(P.ws + WS_KVQZ);
    blk_load(R.k, R.v, P, g, g.nb, tid);
    const int qi = 16 * wave + x15;
    const bf16* QP = (const bf16*)(P.ws + WS_QP) + ((size_t)(g.b * NQH + g.head) * SEQ + (size_t)g.rcl * (SEQ / g.dil) + g.nb * 128 + qi) * 64;
#pragma unroll
    for (int ks = 0; ks < 2; ++ks) R.q[ks] = *(const bf16x8*)(QP + 32 * ks + 8 * G4);
    { const int rel = 159 - tid; R.bias = (tid < 192 && rel >= 0 && rel <= 128) ? P.in[19][t5_bucket(rel * g.dil) * NQH + g.head] : -INFINITY; }
}
DI void prompt_phase(const Params& P, LAS unsigned char* lds, int item0, int iend, int wv) {
    int tid_ = (wv << 6) | lane_id(); asm volatile("" : "+v"(tid_)); const int tid = tid_, lane = tid & 63, wave = __builtin_amdgcn_readfirstlane(tid >> 6);
    const int x15 = lane & 15, G4 = lane >> 4;
    unsigned char* ws = P.ws;
    bf16* OG = (bf16*)(ws + WS_OG); float* LSE = (float*)(ws + WS_LSE);
    int item = item0;
    if (item >= iend) return;
    __syncthreads();
    ItemRegs R; ItemGeo g = item_geo(item);
    int sl = 1;
    {
        v4u pk[2], pv[2];
        if (g.nb > 0) blk_load(pk, pv, P, g, g.nb - 1, tid); else { pk[0] = pk[1] = pv[0] = pv[1] = (v4u){0u, 0u, 0u, 0u}; }
        item_load(R, P, g, tid, wave, x15, G4);
        blk_store(pk, pv, lds + 0 * KBLK, tid);
        blk_store(R.k, R.v, lds + 1 * KBLK, tid);
        if (tid < 192) ((LAS float*)(lds + ABIAS))[tid] = R.bias; }
    bf16x8 qf[2] = {R.q[0], R.q[1]};
    __syncthreads();
    int par = 0;
    for (;;) {
        const int nxt = item + 1; const bool has_next = nxt < iend;
        ItemGeo gn = g;
        if (has_next) { gn = item_geo(nxt); item_load(R, P, gn, tid, wave, x15, G4); }
        const int slp = (sl == 0) ? 2 : sl - 1, sln = (sl == 2) ? 0 : sl + 1;
        const LAS unsigned char* CB = lds + sl * KBLK; const LAS unsigned char* PB = lds + slp * KBLK;
        const int nb = g.nb, dil = g.dil, head = g.head;
        const int qi = 16 * wave + x15; const size_t qrow = g.rowb + (size_t)(nb * 128 + qi) * dil + g.rcl;
        const int base = wave & ~1;
        f32x4 S[10];
        { bf16x8 Af[10][2];
#pragma unroll
          for (int kt = 0; kt < 10; ++kt) { const int T = base + kt; const LAS unsigned char* kb = (T < 8) ? PB : CB; const int key = 16 * (T & 7) + x15;
#pragma unroll
              for (int ks = 0; ks < 2; ++ks) Af[kt][ks] = *(const LAS bf16x8*)(kb + key * 128 + (((4 * ks + G4) ^ (key & 7)) << 4)); }
          SC2_W();
#pragma unroll
          for (int kt = 0; kt < 10; ++kt) { S[kt] = (f32x4){0.f, 0.f, 0.f, 0.f};
#pragma unroll
              for (int ks = 0; ks < 2; ++ks) S[kt] = MFMA16(Af[kt][ks], qf[ks], S[kt]); }
          SC2_SB(); }
        const int i16 = lane & 15, q4 = i16 >> 2, p4 = i16 & 3;
        float bl[10][4]; s16x4 vlo[5][4], vhi[5][4];
        { const LAS float* BL = (const LAS float*)(lds + ABIAS + par * 768) + (4 * G4 - x15 - 16 * (wave - base) + 31);
#pragma unroll
          for (int kt = 0; kt < 10; ++kt)
#pragma unroll
              for (int r = 0; r < 4; ++r) bl[kt][r] = BL[16 * kt + r];
#pragma unroll
          for (int kp = 0; kp < 5; ++kp) {
              const int T0 = base + 2 * kp;
              const int keyr = 16 * (T0 & 7) + 4 * G4 + q4; const int mm = (keyr >> 1) & 3;
              const unsigned vb = (unsigned)(uintptr_t)((T0 < 8) ? PB : CB) + 16384u + (unsigned)(keyr * 128 + 8 * p4);
              const unsigned v0 = vb + (unsigned)((0 ^ mm) << 5), v1 = vb + (unsigned)((1 ^ mm) << 5), v2 = vb + (unsigned)((2 ^ mm) << 5), v3 = vb + (unsigned)((3 ^ mm) << 5);
              asm volatile("ds_read_b64_tr_b16 %0, %8\n\tds_read_b64_tr_b16 %1, %9\n\tds_read_b64_tr_b16 %2, %10\n\tds_read_b64_tr_b16 %3, %11\n\t"
                           "ds_read_b64_tr_b16 %4, %8 offset:2048\n\tds_read_b64_tr_b16 %5, %9 offset:2048\n\tds_read_b64_tr_b16 %6, %10 offset:2048\n\tds_read_b64_tr_b16 %7, %11 offset:2048"
                           : "=&v"(vlo[kp][0]), "=&v"(vlo[kp][1]), "=&v"(vlo[kp][2]), "=&v"(vlo[kp][3]), "=&v"(vhi[kp][0]), "=&v"(vhi[kp][1]), "=&v"(vhi[kp][2]), "=&v"(vhi[kp][3]) : "v"(v0), "v"(v1), "v"(v2), "v"(v3) : "memory"); }
          SC2_W(); }
        float mx = -INFINITY;
#pragma unroll
        for (int kt = 0; kt < 10; ++kt) { const bool dead = (nb == 0) && (base + kt < 8);
#pragma unroll
            for (int r = 0; r < 4; ++r) { const float sl_ = S[kt][r] * 0.125f + bl[kt][r]; const float sv = dead ? -INFINITY : sl_; S[kt][r] = sv; mx = fmaxf(mx, sv); } }
        mx = xmax32(xmax16(mx));
        float sum = 0.f;
#pragma unroll
        for (int kt = 0; kt < 10; ++kt)
#pragma unroll
            for (int r = 0; r < 4; ++r) { const float pe = __builtin_amdgcn_exp2f((S[kt][r] - mx) * 1.4426950408889634f); S[kt][r] = pe; sum += pe; }
        sum = xsum32(xsum16(sum));
        const float rinv = __builtin_amdgcn_rcpf(sum);
        f32x4 O[4];
#pragma unroll
        for (int dt = 0; dt < 4; ++dt) O[dt] = (f32x4){0.f, 0.f, 0.f, 0.f};
#pragma unroll
        for (int kp = 0; kp < 5; ++kp) {
            v4u pb; pb.x = pk2(S[2 * kp][0], S[2 * kp][1]); pb.y = pk2(S[2 * kp][2], S[2 * kp][3]); pb.z = pk2(S[2 * kp + 1][0], S[2 * kp + 1][1]); pb.w = pk2(S[2 * kp + 1][2], S[2 * kp + 1][3]);
            const bf16x8 Bp = __builtin_bit_cast(bf16x8, pb);
#pragma unroll
            for (int dt = 0; dt < 4; ++dt) O[dt] = MFMA16(scan::cat8(vlo[kp][dt], vhi[kp][dt]), Bp, O[dt]);
        }
        bf16* op = OG + qrow * QW + head * 64;
#pragma unroll
        for (int dt = 0; dt < 4; ++dt) { v2u w; w.x = pk2(O[dt][0] * rinv, O[dt][1] * rinv); w.y = pk2(O[dt][2] * rinv, O[dt][3] * rinv); *(v2u*)(op + 16 * dt + 4 * G4) = w; }
        if (G4 == 0) LSE[qrow * NQH + head] = mx + __logf(sum);
        if (!has_next) break;
        blk_store(R.k, R.v, lds + sln * KBLK, tid);
        if (tid < 192) ((LAS float*)(lds + ABIAS + (par ^ 1) * 768))[tid] = R.bias;
        qf[0] = R.q[0]; qf[1] = R.q[1];
        item = nxt; g = gn; par ^= 1; sl = sln;
        __syncthreads();
    }
    __syncthreads();
}

DI void sample_item(const Params& P, int item, int lane) {
    const int head = item % NQH, s = (item / NQH) & 7, b = item / (NQH * 8);
    const int grp = head >> 3, hs = head & 7; const int dil = grp == 0 ? 1 : (grp == 1 ? 4 : 16); const int L = grp == 0 ? 128 : (grp == 1 ? 512 : 2048);
    const float* buf = P.in[5 + grp] + (size_t)b * L * 1024;
    unsigned char* ws = P.ws;
    const bf16* KVQZ = (const bf16*)(ws + WS_KVQZ); bf16* OG = (bf16*)(ws + WS_OG); float* LSE = (float*)(ws + WS_LSE);
    const size_t row = (size_t)TP + b * 8 + s;
    const int kq = lane >> 4, dl = lane & 15;
    f32x4 q; { const v2u qv = *(const v2u*)(KVQZ + row * N2 + 2 * QW + head * 64 + 4 * dl); q = (f32x4){bf_lo(qv.x), bf_hi(qv.x), bf_lo(qv.y), bf_hi(qv.y)}; }
    float m = -INFINITY, l = 0.f; f32x4 acc = (f32x4){0.f, 0.f, 0.f, 0.f};
    for (int j0 = 0; j0 < 132; j0 += 16) {
        f32x4 kv[4], vv[4]; bool ok[4]; float bia[4];
#pragma unroll
        for (int u = 0; u < 4; ++u) { const int j = j0 + 4 * u + kq; ok[u] = j <= 128; kv[u] = (f32x4){0.f, 0.f, 0.f, 0.f}; vv[u] = kv[u]; bia[u] = 0.f;
            if (ok[u]) { const int idx = L + s - dil * j; bia[u] = P.in[19][t5_bucket(dil * j) * NQH + head];
                if (idx >= L) { const size_t r2 = (size_t)TP + b * 8 + (idx - L);
                    const v2u ku = *(const v2u*)(KVQZ + r2 * N2 + head * 64 + 4 * dl), vu = *(const v2u*)(KVQZ + r2 * N2 + QW + head * 64 + 4 * dl);
                    kv[u] = (f32x4){bf_lo(ku.x), bf_hi(ku.x), bf_lo(ku.y), bf_hi(ku.y)}; vv[u] = (f32x4){bf_lo(vu.x), bf_hi(vu.x), bf_lo(vu.y), bf_hi(vu.y)}; }
                else { const float* rp = buf + (size_t)idx * 1024 + hs * 64 + 4 * dl; kv[u] = *(const f32x4*)rp; vv[u] = *(const f32x4*)(rp + 512); } } }
#pragma unroll
        for (int u = 0; u < 4; ++u) {
            float d = (q[0] * kv[u][0] + q[1] * kv[u][1]) + (q[2] * kv[u][2] + q[3] * kv[u][3]);
            d += __shfl_xor(d, 1); d += __shfl_xor(d, 2); d += __shfl_xor(d, 4); d += __shfl_xor(d, 8);
            if (ok[u]) { const float sc = d * 0.125f + bia[u];
                const float mn = fmaxf(m, sc); const float al = __expf(m - mn), p = __expf(sc - mn);
                l = l * al + p; acc = acc * al + vv[u] * p; m = mn; } }
    }
#pragma unroll
    for (int o = 16; o < 64; o <<= 1) { const float m2 = __shfl_xor(m, o), l2 = __shfl_xor(l, o); f32x4 a2; a2[0] = __shfl_xor(acc[0], o); a2[1] = __shfl_xor(acc[1], o); a2[2] = __shfl_xor(acc[2], o); a2[3] = __shfl_xor(acc[3], o);
        const float mn = fmaxf(m, m2); const float f1 = __expf(m - mn), f2 = __expf(m2 - mn); l = l * f1 + l2 * f2; acc = acc * f1 + a2 * f2; m = mn; }
    if (kq == 0) { const float ri = 1.0f / l; v2u w; w.x = pk2(acc[0] * ri, acc[1] * ri); w.y = pk2(acc[2] * ri, acc[3] * ri); *(v2u*)(OG + row * QW + head * 64 + 4 * dl) = w;
        if (dl == 0) LSE[row * NQH + head] = m + __logf(l); }
}
}

DI void merge_phase(const Params& P, int vcu, int G, int wv) {
    int tid_ = (wv << 6) | lane_id(); asm volatile("" : "+v"(tid_));
    unsigned char* ws = P.ws;
    const bf16* KVQZ = (const bf16*)(ws + WS_KVQZ); const bf16* OG = (const bf16*)(ws + WS_OG); const float* LSE = (const float*)(ws + WS_LSE); bf16* A5 = (bf16*)(ws + WS_A5);
    const size_t total = (size_t)M * 64;
    for (size_t i = (size_t)vcu * NTHR + tid_; i < total; i += (size_t)G * NTHR) {
        const size_t row = i >> 6; const int hs = (int)(i & 63) >> 3, d8 = (int)(i & 7) * 8;
        const float l0 = LSE[row * NQH + hs], l1 = LSE[row * NQH + 8 + hs], l2 = LSE[row * NQH + 16 + hs];
        const float mx = fmaxf(l0, fmaxf(l1, l2)); float w0 = __expf(l0 - mx), w1 = __expf(l1 - mx), w2 = __expf(l2 - mx); const float ri = 1.0f / (w0 + w1 + w2); w0 *= ri; w1 *= ri; w2 *= ri;
        const v4u a = __builtin_nontemporal_load((const v4u*)(OG + row * QW + hs * 64 + d8)), bq = __builtin_nontemporal_load((const v4u*)(OG + row * QW + 512 + hs * 64 + d8)), cq = __builtin_nontemporal_load((const v4u*)(OG + row * QW + 1024 + hs * 64 + d8));
        const v4u z = __builtin_nontemporal_load((const v4u*)(KVQZ + row * N2 + 3 * QW + hs * 64 + d8));
        v4u o;
#define MRG(f) { const float zl = bf_lo(z.f), zh = bf_hi(z.f); \
        const float vl = (w0 * bf_lo(a.f) + w1 * bf_lo(bq.f) + w2 * bf_lo(cq.f)) * zl * fsigmoid(zl); \
        const float vh = (w0 * bf_hi(a.f) + w1 * bf_hi(bq.f) + w2 * bf_hi(cq.f)) * zh * fsigmoid(zh); o.f = pk2(vl, vh); }
        MRG(x) MRG(y) MRG(z) MRG(w)
#undef MRG
        *(v4u*)(A5 + row * AOUT + hs * 64 + d8) = o;
    }
}

#ifndef REP_P0
#define REP_P0 1
#endif
#ifndef REP_G1
#define REP_G1 1
#endif
#ifndef REP_SCAN
#define REP_SCAN 1
#endif
#ifndef REP_SSCAN
#define REP_SSCAN 1
#endif
#ifndef REP_G3
#define REP_G3 1
#endif
#ifndef REP_G4
#define REP_G4 1
#endif
#ifndef REP_ATT
#define REP_ATT 1
#endif
#ifndef REP_SATT
#define REP_SATT 1
#endif
#ifndef REP_MERGE
#define REP_MERGE 1
#endif

constexpr int SG_LD = 68, SG_PW = 64 * SG_LD;
template <class F> DI void sgemm_tile(LAS unsigned char* lds, const bf16* A, int K, const bf16* Wt, int mt, int nt, int wv, const F& f) {
    const int lane = lane_id(), tid = (wv << 6) | lane, r = lane & 15, g = lane >> 4;
    const int kw = K >> 3, k0w = wv * kw;
    f32x4 acc[4][4];
#pragma unroll
    for (int m = 0; m < 4; ++m)
#pragma unroll
        for (int n = 0; n < 4; ++n) acc[m][n] = (f32x4){0.f, 0.f, 0.f, 0.f};
    const bf16* ap = A + (size_t)(64 * mt + r) * K + k0w + 8 * g; const bf16* bp = Wt + (size_t)(64 * nt + r) * K + k0w + 8 * g;
    for (int ks = 0; ks < (kw >> 5); ++ks) {
        bf16x8 a[4], b[4];
#pragma unroll
        for (int m = 0; m < 4; ++m) { a[m] = *(const bf16x8*)(ap + (size_t)(16 * m) * K + 32 * ks); b[m] = *(const bf16x8*)(bp + (size_t)(16 * m) * K + 32 * ks); }
#pragma unroll
        for (int m = 0; m < 4; ++m)
#pragma unroll
            for (int n = 0; n < 4; ++n) acc[m][n] = MFMA16(a[m], b[n], acc[m][n]);
    }
    __syncthreads();
    LAS float* Pw = (LAS float*)lds + wv * SG_PW;
#pragma unroll
    for (int m = 0; m < 4; ++m)
#pragma unroll
        for (int n = 0; n < 4; ++n)
#pragma unroll
            for (int i = 0; i < 4; ++i) Pw[(16 * m + 4 * g + i) * SG_LD + 16 * n + r] = acc[m][n][i];
    __syncthreads();
    f(tid >> 3, 8 * (tid & 7), (const LAS float*)lds);
    __syncthreads();
}
__global__ void __launch_bounds__(NTHR, 2) yoco_fwd(Params P) {
    extern __shared__ __attribute__((aligned(16))) unsigned char lds_raw[];
    LAS unsigned char* lds = (LAS unsigned char*)lds_raw;
    cg::grid_group grid = cg::this_grid();
    const int G = gridDim.x, bx = blockIdx.x;
    const int wv = __builtin_amdgcn_readfirstlane(threadIdx.x >> 6);
    unsigned char* ws = P.ws;
    int vcu, vrr;
    {
        LAS int* sh = (LAS int*)(lds + LDS_BYTES - 16);
        if (threadIdx.x == 0) {
            unsigned* cnt = (unsigned*)(ws + WS_CTL);
            const unsigned xcc = (unsigned)__builtin_amdgcn_s_getreg((3 << 11) | 20) & 7u;
            const unsigned t = __hip_atomic_fetch_add(cnt + 64 * xcc, 1u, __ATOMIC_RELAXED, __HIP_MEMORY_SCOPE_AGENT);
            unsigned c[8]; unsigned sum = 0; unsigned spins = 0;
            for (;;) { sum = 0;
#pragma unroll
                for (int j = 0; j < 8; ++j) { c[j] = __hip_atomic_load(cnt + 64 * j, __ATOMIC_RELAXED, __HIP_MEMORY_SCOPE_AGENT); sum += c[j]; }
                if (sum == (unsigned)G || ++spins > (1u << 20)) break;
                __builtin_amdgcn_s_sleep(1); }
            bool bal = (sum == (unsigned)G) && (G % 8 == 0);
#pragma unroll
            for (int j = 0; j < 8; ++j) bal = bal && (c[j] == (unsigned)(G / 8));
            if (bal) { sh[0] = (int)(xcc * (unsigned)(G / 8) + t); sh[1] = (int)(t * 8 + xcc); }
            else { sh[0] = (G % 8 == 0) ? (bx % 8) * (G / 8) + bx / 8 : bx; sh[1] = bx; }
        }
        __syncthreads();
        vcu = __builtin_amdgcn_readfirstlane(sh[0]); vrr = __builtin_amdgcn_readfirstlane(sh[1]);
        __syncthreads();
    }
    if (gridDim.x == 0x7fffffffu) grid.sync();
    volatile LAS unsigned* bst = (volatile LAS unsigned*)(lds + LDS_BYTES - 32);
    if (threadIdx.x < 2) bst[threadIdx.x] = 0u;
    __syncthreads();
    XcdBarrier xbar = xcd_barrier_post((unsigned*)(ws + WS_CTL + 16384), bst, wv);
#define GSYNC() xcd_barrier(xbar)

    constexpr int P0_IA = 16 * 320, P0_NIT = 16 * 320 + 32 * 32 + 16 * 160 + 8 * 32;
    const bool split0 = (G == 256);
#ifndef NO_P0
    if (split0) {
        p0_phase(P, lds, wv, true, 0, P0_IA, TP, M, P.in[1], vcu, G);
        xcd_arrive(xbar, 2);
        if (vrr < 40) {
            xcd_wait(xbar, 2);
            pg8::Gemm g{(const bf16*)(ws + WS_XN) + (size_t)TP * D, (const bf16*)(ws + WS_WA), TS, NP1, D}; pg8::StaticOrder S; S.init(TS, NP1, G, vrr);
            pg8::EpiP1 E{(bf16*)(ws + WS_P1), NP1, TP};
            pg8::gemm_phase<pg8::EpiP1, true, true>(lds, g, S, E, wv);
        } else p0_phase(P, lds, wv, false, P0_IA, P0_NIT, 0, TP, P.in[0], vrr - 40, G - 40);
    } else { p0_phase(P, lds, wv, true, 0, P0_NIT, 0, TP, P.in[0], vcu, G); p0_phase(P, lds, wv, false, 0, 0, TP, M, P.in[1], vcu, G); }
#endif
    GSYNC();
    { pg8::Gemm g{(const bf16*)(ws + WS_XN), (const bf16*)(ws + WS_WA), split0 ? TP : M, NP1, D}; pg8::StaticOrder S; S.init(split0 ? TP : M, NP1, G, vrr);
      pg8::EpiP1 E{(bf16*)(ws + WS_P1), NP1, 0};
#ifndef NO_G1
      for (int rep_ = 0; rep_ < REP_G1; ++rep_) { pg8::gemm_phase<pg8::EpiP1, true, true>(lds, g, S, E, wv); }
#endif
 }
    GSYNC();
#ifndef NO_SCAN
    for (int rep_ = 0; rep_ < REP_SCAN; ++rep_) { for (int it = vrr; it < BATCH * NH * 8; it += G) scan2::prompt_scan<0>(P, lds, it, wv); }
#ifdef PROBE_MODE
    for (int it = vrr; it < BATCH * NH * 8; it += G) scan2::prompt_scan<PROBE_MODE>(P, lds, it, wv);
#endif
#endif
#ifndef NO_SSCAN
    for (int rep_ = 0; rep_ < REP_SSCAN; ++rep_) { for (int it = vcu; it < DECB * NH * 8; it += G) sscan::sample_item(P, lds, it, wv); }
#endif
    GSYNC();
    for (int it = vcu; it < 64; it += G) { const int mt = it >> 4, nt = it & 15;
        const float* hss = (const float*)(ws + WS_HSS); const float* xs = P.in[1]; float* outp = P.out + O_Y; bf16* xb = (bf16*)(ws + WS_XN); float* ss1 = (float*)(ws + WS_SS1);
        auto f3 = [&](int row, int c8, const LAS float* Pp) { const int srow = 64 * mt + row; const size_t grow = (size_t)TP + srow; float fh[4];
#pragma unroll
            for (int h = 0; h < 4; ++h) { const f32x4 a = *(const f32x4*)(hss + grow * 32 + h * 8), b2 = *(const f32x4*)(hss + grow * 32 + h * 8 + 4);
                fh[h] = __builtin_amdgcn_rsqf(((a[0] + a[1]) + (a[2] + a[3]) + (b2[0] + b2[1]) + (b2[2] + b2[3])) * (1.0f / 512.0f) + EPS); }
            f32x4 s0 = (f32x4){0.f, 0.f, 0.f, 0.f}, s1 = s0;
#pragma unroll
            for (int w = 0; w < 8; ++w) { const LAS float* q = Pp + w * SG_PW + row * SG_LD + c8; s0 += *(const LAS f32x4*)q * fh[w >> 1]; s1 += *(const LAS f32x4*)(q + 4) * fh[w >> 1]; }
            const size_t o = (size_t)srow * D + 64 * nt + c8; const f32x4 x0 = *(const f32x4*)(xs + o) + s0, x1 = *(const f32x4*)(xs + o + 4) + s1;
            v4u wq; wq.x = pk2(x0[0], x0[1]); wq.y = pk2(x0[2], x0[3]); wq.z = pk2(x1[0], x1[1]); wq.w = pk2(x1[2], x1[3]); *(v4u*)(xb + grow * D + 64 * nt + c8) = wq;
            float ssq = (x0[0] * x0[0] + x0[1] * x0[1]) + (x0[2] * x0[2] + x0[3] * x0[3]) + (x1[0] * x1[0] + x1[1] * x1[1]) + (x1[2] * x1[2] + x1[3] * x1[3]);
            ssq += __shfl_xor(ssq, 1); ssq += __shfl_xor(ssq, 2); ssq += __shfl_xor(ssq, 4);
            if (c8 == 0) ss1[grow * 16 + nt] = ssq; };
        sgemm_tile(lds, (const bf16*)(ws + WS_A3) + (size_t)TP * DI_, DI_, (const bf16*)(ws + WS_WOA), mt, nt, wv, f3); }
    { pg8::Gemm g{(const bf16*)(ws + WS_A3), (const bf16*)(ws + WS_WOA), TP, D, DI_}; pg8::StaticOrder S; S.init(TP, D, G, vrr);
      pg8::EpiG3 E{(const float*)(ws + WS_HSS), (const bf16*)(ws + WS_XN), (const float*)(ws + WS_RNORM), P.out + O_Y, (bf16*)(ws + WS_XN), (float*)(ws + WS_SS1)};
#ifndef NO_G3
      for (int rep_ = 0; rep_ < REP_G3; ++rep_) { pg8::gemm_phase<pg8::EpiG3, true, true>(lds, g, S, E, wv); }
#endif
 }
    GSYNC();
    const bool split4 = (G == 256);
    { pg8::Gemm g{(const bf16*)(ws + WS_XN), (const bf16*)(ws + WS_W2), split4 ? TP : M, N2, D}; pg8::StaticOrder S; S.init(split4 ? TP : M, N2, G, vrr);
      pg8::EpiG4 E{(const float*)(ws + WS_SS1), P.in[15], P.in[18], (bf16*)(ws + WS_KVQZ), ws, P.out, 0};
#ifndef NO_G4
      for (int rep_ = 0; rep_ < REP_G4; ++rep_) { pg8::gemm_phase<pg8::EpiG4, true, true>(lds, g, S, E, wv); }
#endif
 }
    int a_item0, a_iend;
    if (split4) {
        xcd_arrive(xbar, 0);
        if (vrr < 20) {
            pg8::Gemm g{(const bf16*)(ws + WS_XN) + (size_t)TP * D, (const bf16*)(ws + WS_W2), TS, N2, D}; pg8::StaticOrder S; S.init(TS, N2, G, vrr);
            pg8::EpiG4 E{(const float*)(ws + WS_SS1), P.in[15], P.in[18], (bf16*)(ws + WS_KVQZ), ws, P.out, TP};
            pg8::gemm_phase<pg8::EpiG4, true, true>(lds, g, S, E, wv);
            cnt_signal(xbar, 0);
        }
        xcd_wait(xbar, 0);
        if (vrr < 20) { a_item0 = 18 * vrr; a_iend = a_item0 + 18; }
        else { const int r = vrr - 20; a_item0 = 360 + 24 * r + (r < 120 ? r : 120); a_iend = a_item0 + (r < 120 ? 25 : 24); }
    } else {
        GSYNC();
        const int per = (attn::NITEMS + G - 1) / G; a_item0 = vcu * per; a_iend = (a_item0 + per < attn::NITEMS) ? a_item0 + per : attn::NITEMS;
    }
#ifndef NO_ATT
    for (int rep_ = 0; rep_ < REP_ATT; ++rep_) { attn::prompt_phase(P, lds, a_item0, a_iend, wv); }
#endif
    if (split4) cnt_wait(xbar, 0, 20u);
    { const int wave = wv;
#ifndef NO_SATT
      for (int rep_ = 0; rep_ < REP_SATT; ++rep_) { for (int it = vcu * 8 + wave; it < TS * NQH; it += G * 8) attn::sample_item(P, it, lane_id()); }
#endif
 }
    GSYNC();
#ifndef NO_MERGE
    for (int rep_ = 0; rep_ < REP_MERGE; ++rep_) { merge_phase(P, vcu, G, wv); }
#endif
    GSYNC();
    for (int it = vcu; it < 64; it += G) { const int mt = it >> 4, nt = it & 15; float* outp = P.out + O_Y;
        auto f5 = [&](int row, int c8, const LAS float* Pp) { const size_t grow = (size_t)TP + 64 * mt + row; f32x4 s0 = (f32x4){0.f, 0.f, 0.f, 0.f}, s1 = s0;
#pragma unroll
            for (int w = 0; w < 8; ++w) { const LAS float* q = Pp + w * SG_PW + row * SG_LD + c8; s0 += *(const LAS f32x4*)q; s1 += *(const LAS f32x4*)(q + 4); }
            const v4u xq = *(const v4u*)((const bf16*)(ws + WS_XN) + grow * D + 64 * nt + c8); float* o = outp + grow * D + 64 * nt + c8;
            *(f32x4*)o = (f32x4){bf_lo(xq.x), bf_hi(xq.x), bf_lo(xq.y), bf_hi(xq.y)} + s0; *(f32x4*)(o + 4) = (f32x4){bf_lo(xq.z), bf_hi(xq.z), bf_lo(xq.w), bf_hi(xq.w)} + s1; };
        sgemm_tile(lds, (const bf16*)(ws + WS_A5) + (size_t)TP * AOUT, AOUT, (const bf16*)(ws + WS_WOB), mt, nt, wv, f5); }
    { pg8::Gemm g{(const bf16*)(ws + WS_A5), (const bf16*)(ws + WS_WOB), TP, D, AOUT}; pg8::StaticOrder S; S.init(TP, D, G, vrr);
      pg8::EpiG5 E{P.out + O_Y, (const bf16*)(ws + WS_XN)};
#ifndef NO_G5
      pg8::gemm_phase<pg8::EpiG5, true, true>(lds, g, S, E, wv);
#endif
 }
}

extern "C" void kernel_launch(void* const* d_in, const int* in_sizes, int n_in, void* d_out, int out_size, void* d_ws, size_t ws_size, hipStream_t stream) {
    static int grid = 0;
    if (grid == 0) {
        if (n_in != 21 || (size_t)out_size != O_END || ws_size < WS_NEED) { fprintf(stderr, "kernel_launch: unexpected sizes n_in %d out %d (want %zu) ws %zu (want %zu)\n", n_in, out_size, (size_t)O_END, ws_size, (size_t)WS_NEED); grid = -1; return; }
        int dev = 0, cus = 0, per_cu = 0;
        (void)hipGetDevice(&dev); (void)hipDeviceGetAttribute(&cus, hipDeviceAttributeMultiprocessorCount, dev);
        if (hipFuncSetAttribute((const void*)yoco_fwd, hipFuncAttributeMaxDynamicSharedMemorySize, LDS_BYTES) != hipSuccess) { fprintf(stderr, "kernel_launch: hipFuncSetAttribute failed\n"); grid = -1; return; }
        if (hipOccupancyMaxActiveBlocksPerMultiprocessor(&per_cu, (const void*)yoco_fwd, NTHR, LDS_BYTES) != hipSuccess || per_cu < 1) { fprintf(stderr, "kernel_launch: occupancy query says %d\n", per_cu); per_cu = 1; }
        (void)hipGetLastError();
        grid = cus * 1;
        fprintf(stderr, "kernel_launch: cus %d per_cu %d grid %d\n", cus, per_cu, grid);
    }
    if (grid < 0) return;
    (void)hipMemsetAsync((char*)d_ws + WS_CTL, 0, 65536, stream);
    Params p{};
    for (int i = 0; i < 21; ++i) p.in[i] = (const float*)d_in[i];
    p.out = (float*)d_out; p.ws = (unsigned char*)d_ws;
    void* args[] = {&p};
    hipError_t e = hipLaunchCooperativeKernel((const void*)yoco_fwd, dim3(grid), dim3(NTHR), args, LDS_BYTES, stream);
    if (e != hipSuccess) fprintf(stderr, "cooperative launch failed: %s (grid %d)\n", hipGetErrorString(e), grid);
}
```
